# Optimizing an MI355X kernel written in HIP

```python
import math
import jax, jax.numpy as jnp
from jax import lax
import numpy as np

D_MODEL = 1024
BATCH = 4
SEQ = 8192
DEPTH = 1

CTX_LEN = 256
GRID_W = 64
CHUNK = 64
EPS = 1e-6
A_HEADS = 8
A_DK = 128
A_DV = 128
A_CONV = 3
B_HEADS = 8
B_DK = 128
B_DV = 128
P_HEADS = 8
P_NKEYS = 128
P_EXPERTS = P_NKEYS * P_NKEYS
P_TOPK = 16
P_DQ = 128
P_BLOCK = 128

A_QKV = A_HEADS * (2 * A_DK + A_DV)
A_GATE = A_HEADS * A_DV
A_AB = 4 * A_HEADS
B_QK = B_HEADS * B_DK
B_V = B_HEADS * B_DV
MERGE_G = 2 * D_MODEL
SPLIT_IDX = (A_QKV,
             A_QKV + A_GATE,
             A_QKV + A_GATE + A_AB,
             A_QKV + A_GATE + A_AB + B_QK,
             A_QKV + A_GATE + A_AB + 3 * B_QK,
             A_QKV + A_GATE + A_AB + 3 * B_QK + B_V,
             A_QKV + A_GATE + A_AB + 3 * B_QK + 2 * B_V)
N_IN = A_QKV + A_GATE + A_AB + 3 * B_QK + 2 * B_V + MERGE_G

kernel_name = 'hybrid_gdn_hgrn2_peer_prefix_dit'


def _rmsnorm(x, w):
    xf = x.astype(jnp.float32)
    y = xf * lax.rsqrt(jnp.mean(xf * xf, axis=-1, keepdims=True) + EPS)
    return (y * w.astype(jnp.float32)).astype(x.dtype)


def _l2norm(x):
    return x * lax.rsqrt(jnp.sum(x * x, axis=-1, keepdims=True) + EPS)


def _modulate(xn, shift, scale):
    return xn * (1 + scale) + shift


def _heads(x, n_heads):
    b, l, _ = x.shape
    return x.reshape(b, l, n_heads, -1).transpose(0, 2, 1, 3)


def _unheads(x):
    b, h, l, d = x.shape
    return x.transpose(0, 2, 1, 3).reshape(b, l, h * d)


def _flip(t):
    return jnp.flip(t, axis=2)


def _short_conv(x, w):
    pad = w.shape[0] // 2
    return lax.conv_general_dilated(x, w[:, None, :].astype(x.dtype), window_strides=(1,),
                                    padding=[(pad, pad)], dimension_numbers=('NWC', 'WIO', 'NWC'),
                                    feature_group_count=x.shape[-1])


def _gdn_chunked(q, k, v, g, beta, s0):
    b, h, L, _ = q.shape
    dv = v.shape[-1]
    n = L // CHUNK
    q, k, v = (t.reshape(b, h, n, CHUNK, -1) for t in (q, k, v))
    g, beta = (t.reshape(b, h, n, CHUNK) for t in (g, beta))
    gc = jnp.cumsum(g, axis=-1)
    incl = jnp.tril(jnp.ones((CHUNK, CHUNK), bool))
    strict = jnp.tril(jnp.ones((CHUNK, CHUNK), bool), -1)
    diff = gc[..., :, None] - gc[..., None, :]
    decay = jnp.where(incl, jnp.exp(jnp.where(incl, diff, 0.0)), 0.0)
    kb = k * beta[..., None]
    m = jnp.where(strict, jnp.einsum('bhnid,bhnjd->bhnij', kb, k) * decay, 0.0)
    a = m + jnp.eye(CHUNK, dtype=m.dtype)
    rhs = jnp.concatenate([v * beta[..., None], kb * jnp.exp(gc)[..., None]], axis=-1)
    sol = lax.linalg.triangular_solve(a, rhs, left_side=True, lower=True, unit_diagonal=True)
    u, w = sol[..., :dv], sol[..., dv:]
    qk = jnp.einsum('bhnid,bhnjd->bhnij', q, k) * decay
    q_dec = q * jnp.exp(gc)[..., None]
    k_dec = k * jnp.exp(gc[..., -1:] - gc)[..., None]
    tot = jnp.exp(gc[..., -1])

    def step(S, xs):
        u_c, w_c, qd_c, kd_c, qk_c, tot_c = xs
        v_new = u_c - jnp.einsum('bhcd,bhdv->bhcv', w_c, S)
        o_c = jnp.einsum('bhcd,bhdv->bhcv', qd_c, S) + jnp.einsum('bhij,bhjv->bhiv', qk_c, v_new)
        S = tot_c[..., None, None] * S + jnp.einsum('bhcd,bhcv->bhdv', kd_c, v_new)
        return S, o_c

    xs = tuple(jnp.moveaxis(t, 2, 0) for t in (u, w, q_dec, k_dec, qk, tot))
    s_fin, o = lax.scan(step, s0, xs)
    return jnp.moveaxis(o, 0, 2).reshape(b, h, L, dv), s_fin


def _gla_chunked(q, k, v, logf, s0):
    b, h, L, _ = q.shape
    dv = v.shape[-1]
    n = L // CHUNK
    q, k, v, logf = (t.reshape(b, h, n, CHUNK, -1) for t in (q, k, v, logf))
    bc = jnp.cumsum(logf, axis=3)
    ref = bc[..., CHUNK // 2:CHUNK // 2 + 1, :]
    incl = jnp.tril(jnp.ones((CHUNK, CHUNK), bool))
    scores = jnp.einsum('bhnid,bhnjd->bhnij', q * jnp.exp(bc - ref), k * jnp.exp(ref - bc))
    scores = jnp.where(incl, scores, 0.0)
    o_intra = jnp.einsum('bhnij,bhnjv->bhniv', scores, v)
    q_dec = q * jnp.exp(bc)
    k_dec = k * jnp.exp(bc[..., -1:, :] - bc)
    tot = jnp.exp(bc[..., -1, :])

    def step(S, xs):
        qd_c, kd_c, v_c, tot_c = xs
        o_c = jnp.einsum('bhcd,bhdv->bhcv', qd_c, S)
        S = tot_c[..., :, None] * S + jnp.einsum('bhcd,bhcv->bhdv', kd_c, v_c)
        return S, o_c

    xs = tuple(jnp.moveaxis(t, 2, 0) for t in (q_dec, k_dec, v, tot))
    s_fin, o_inter = lax.scan(step, s0, xs)
    o = o_intra + jnp.moveaxis(o_inter, 0, 2)
    return o.reshape(b, h, L, dv), s_fin


def _gdn_branch(qkv, gate, ab, conv_w, a_log, dt_bias, norm_w, s0):
    f32 = jnp.float32
    dtype = qkv.dtype
    b, L, _ = qkv.shape
    qkv = jax.nn.silu(_short_conv(qkv, conv_w)).astype(f32)
    q, k, v = jnp.split(qkv, [A_HEADS * A_DK, 2 * A_HEADS * A_DK], axis=-1)
    q = _l2norm(_heads(q, A_HEADS)) * (A_DK ** -0.5)
    k = _l2norm(_heads(k, A_HEADS))
    v = _heads(v, A_HEADS)
    ab = ab.astype(f32).reshape(b, L, 4, A_HEADS).transpose(0, 2, 3, 1)
    g = -jnp.exp(a_log.astype(f32))[None, :, :, None] * jax.nn.softplus(
        ab[:, :2] + dt_bias.astype(f32)[None, :, :, None])
    beta = jax.nn.sigmoid(ab[:, 2:])
    o_f, s_f = _gdn_chunked(q, k, v, g[:, 0], beta[:, 0], s0[0])
    o_b, s_b = _gdn_chunked(_flip(q), _flip(k), _flip(v), _flip(g[:, 1]), _flip(beta[:, 1]), s0[1])
    o = o_f + _flip(o_b)
    o = _rmsnorm(o, norm_w) * jax.nn.silu(_heads(gate.astype(f32), A_HEADS))
    return _unheads(o).astype(dtype), (s_f, s_b)


def _hgrn2_branch(q, f2, i, gate, lb, norm_w, s0):
    f32 = jnp.float32
    dtype = q.dtype
    q = _heads(jax.nn.silu(q.astype(f32)), B_HEADS) * (B_DK ** -0.5)
    v = _heads(i.astype(f32), B_HEADS)
    lb = lb.astype(f32)

    def forget(fx):
        f = lb + (1 - lb) * jax.nn.sigmoid(fx)
        return _heads(jnp.log(f), B_HEADS), _heads(1 - f, B_HEADS)

    ff, fb = jnp.split(f2.astype(f32), 2, axis=-1)
    logf_f, k_f = forget(ff)
    logf_b, k_b = forget(fb)
    o_f, s_f = _gla_chunked(q, k_f, v, logf_f, s0[0])
    o_b, s_b = _gla_chunked(_flip(q), _flip(k_b), _flip(v), _flip(logf_b), s0[1])
    o = o_f + _flip(o_b)
    o = _rmsnorm(o, norm_w) * jax.nn.silu(_heads(gate.astype(f32), B_HEADS))
    return _unheads(o).astype(dtype), (s_f, s_b)


def _token_mixers(h, hc, need_ctx, w_in, conv_w, a_log, dt_bias, gdn_norm_w, lb, hg_norm_w, w_pa, w_pb, w_o):
    b, s, _ = h.shape
    rows = s // GRID_W
    qkv, ga, ab, qb, fb2, ib, gb, mg = jnp.split(h @ w_in, SPLIT_IDX, axis=-1)
    qkv_c, ga_c, ab_c, qb_c, fb2_c, ib_c, gb_c, mg_c = jnp.split(hc @ w_in, SPLIT_IDX, axis=-1)
    za = jnp.zeros((b, A_HEADS, A_DK, A_DV), jnp.float32)
    zb = jnp.zeros((b, B_HEADS, B_DK, B_DV), jnp.float32)
    oa_c, sa = _gdn_branch(qkv_c, ga_c, ab_c, conv_w, a_log, dt_bias, gdn_norm_w, (za, za))
    oa, _ = _gdn_branch(qkv, ga, ab, conv_w, a_log, dt_bias, gdn_norm_w, sa)
    to_col = lambda t: t.reshape(b, rows, GRID_W, -1).transpose(0, 2, 1, 3).reshape(b, s, -1)
    from_col = lambda t: t.reshape(b, GRID_W, rows, -1).transpose(0, 2, 1, 3).reshape(b, s, -1)
    ob_c, sb = _hgrn2_branch(qb_c, fb2_c, ib_c, gb_c, lb, hg_norm_w, (zb, zb))
    ob, _ = _hgrn2_branch(to_col(qb), to_col(fb2), to_col(ib), to_col(gb), lb, hg_norm_w, sb)
    ob = from_col(ob)

    def merge(o_a, o_b, gates):
        g_a, g_b = jnp.split(jax.nn.sigmoid(gates), 2, axis=-1)
        return (g_a * (o_a @ w_pa) + g_b * (o_b @ w_pb)) @ w_o

    mix = merge(oa, ob, mg)
    mix_c = merge(oa_c, ob_c, mg_c) if need_ctx else None
    return mix, mix_c


def _peer(h, w_query, sub_keys, expert_u, expert_v):
    b, s, d = h.shape
    n_tok = b * s
    t = h.reshape(n_tok, d)
    q = (t @ w_query).reshape(n_tok, P_HEADS, 2, P_DQ)
    sc = jnp.einsum('thcd,hckd->thck', q, sub_keys)
    s1, i1 = lax.top_k(sc[:, :, 0], P_TOPK)
    s2, i2 = lax.top_k(sc[:, :, 1], P_TOPK)
    cand = (s1[..., :, None] + s2[..., None, :]).reshape(n_tok, P_HEADS, P_TOPK * P_TOPK)
    top_s, top_i = lax.top_k(cand, P_TOPK)
    e1 = jnp.take_along_axis(i1, top_i // P_TOPK, axis=-1)
    e2 = jnp.take_along_axis(i2, top_i % P_TOPK, axis=-1)
    nb = n_tok // P_BLOCK
    experts = (e1 * P_NKEYS + e2).reshape(nb, P_BLOCK, P_HEADS * P_TOPK)
    gates = jax.nn.softmax(top_s.astype(jnp.float32), axis=-1).astype(h.dtype)
    gates = gates.reshape(nb, P_BLOCK, P_HEADS * P_TOPK)

    def block(args):
        tb, eb, gb = args
        act = jax.nn.gelu(jnp.einsum('td,tkd->tk', tb, expert_u[eb]), approximate=False) * gb
        return jnp.einsum('tk,tkd->td', act, expert_v[eb])

    y = lax.map(block, (t.reshape(nb, P_BLOCK, d), experts, gates))
    return y.reshape(b, s, d)


def setup_inputs(seed: int = 0) -> dict:
    key = jax.random.key(seed)
    ks = jax.random.split(key, 24)
    f32 = jnp.float32
    nrm = lambda k, shape, scale: jax.random.normal(k, shape, f32) * scale
    dt = jnp.exp(jax.random.uniform(ks[10], (DEPTH, 2, A_HEADS), f32, math.log(1e-3), math.log(1e-1)))
    return {
        'x': nrm(ks[0], (BATCH, SEQ, D_MODEL), 1.0),
        'c': nrm(ks[1], (BATCH, D_MODEL), 1.0),
        'ctx': nrm(ks[2], (BATCH, CTX_LEN, D_MODEL), 1.0),
        'c_ctx': nrm(ks[3], (D_MODEL,), 1.0),
        'w_ada': nrm(ks[4], (DEPTH, D_MODEL, 6 * D_MODEL), 0.5 * D_MODEL ** -0.5),
        'b_ada': nrm(ks[5], (DEPTH, 6 * D_MODEL), 0.02),
        'norm1_w': 1.0 + nrm(ks[6], (DEPTH, D_MODEL), 0.02),
        'w_in': nrm(ks[7], (DEPTH, D_MODEL, N_IN), D_MODEL ** -0.5),
        'conv_w': nrm(ks[8], (DEPTH, A_CONV, A_QKV), A_CONV ** -0.5),
        'a_log': jnp.log(jax.random.uniform(ks[9], (DEPTH, 2, A_HEADS), f32, 1.0, 16.0)),
        'dt_bias': dt + jnp.log(-jnp.expm1(-dt)),
        'gdn_norm_w': 1.0 + nrm(ks[11], (DEPTH, A_DV), 0.02),
        'lb_logits': nrm(ks[12], (DEPTH + 1, B_HEADS * B_DK), 0.1),
        'hg_norm_w': 1.0 + nrm(ks[13], (DEPTH, B_DV), 0.02),
        'w_pa': nrm(ks[14], (DEPTH, A_HEADS * A_DV, D_MODEL), (A_HEADS * A_DV) ** -0.5),
        'w_pb': nrm(ks[15], (DEPTH, B_HEADS * B_DV, D_MODEL), (B_HEADS * B_DV) ** -0.5),
        'w_o': nrm(ks[16], (DEPTH, D_MODEL, D_MODEL), D_MODEL ** -0.5),
        'norm2_w': 1.0 + nrm(ks[17], (DEPTH, D_MODEL), 0.02),
        'w_query': nrm(ks[18], (DEPTH, D_MODEL, P_HEADS * 2 * P_DQ), D_MODEL ** -0.5),
        'sub_keys': nrm(ks[19], (DEPTH, P_HEADS, 2, P_NKEYS, P_DQ), P_DQ ** -0.5),
        'expert_u': nrm(ks[20], (DEPTH, P_EXPERTS, D_MODEL), D_MODEL ** -0.5),
        'expert_v': nrm(ks[21], (DEPTH, P_EXPERTS, D_MODEL), D_MODEL ** -0.5),
        'final_norm_w': 1.0 + nrm(ks[22], (D_MODEL,), 0.02),
    }


def reference(x, c, ctx, c_ctx, w_ada, b_ada, norm1_w, w_in, conv_w, a_log, dt_bias, gdn_norm_w,
              lb_logits, hg_norm_w, w_pa, w_pb, w_o, norm2_w, w_query, sub_keys, expert_u, expert_v,
              final_norm_w):
    lb_all = jnp.cumsum(jax.nn.softmax(lb_logits.astype(jnp.float32), axis=0), axis=0)
    xc = ctx
    for l in range(DEPTH):
        last = l == DEPTH - 1
        mod = jax.nn.silu(c) @ w_ada[l] + b_ada[l]
        mod_c = jax.nn.silu(c_ctx) @ w_ada[l] + b_ada[l]
        sh1, sc1, g1, sh2, sc2, g2 = jnp.split(mod[:, None, :], 6, axis=-1)
        sh1c, sc1c, g1c, sh2c, sc2c, g2c = jnp.split(mod_c, 6, axis=-1)
        h = _modulate(_rmsnorm(x, norm1_w[l]), sh1, sc1)
        hc = _modulate(_rmsnorm(xc, norm1_w[l]), sh1c, sc1c)
        mix, mix_c = _token_mixers(h, hc, not last, w_in[l], conv_w[l], a_log[l], dt_bias[l], gdn_norm_w[l],
                                   lb_all[l], hg_norm_w[l], w_pa[l], w_pb[l], w_o[l])
        x = x + g1 * mix
        x = x + g2 * _peer(_modulate(_rmsnorm(x, norm2_w[l]), sh2, sc2),
                           w_query[l], sub_keys[l], expert_u[l], expert_v[l])
        if not last:
            xc = xc + g1c * mix_c
            xc = xc + g2c * _peer(_modulate(_rmsnorm(xc, norm2_w[l]), sh2c, sc2c),
                                  w_query[l], sub_keys[l], expert_u[l], expert_v[l])
    return _rmsnorm(x, final_norm_w)
```

```cpp
#include <hip/hip_runtime.h>
#include <cstdio>
#include <cstdint>

#define GAS __attribute__((address_space(1)))
#define LAS __attribute__((address_space(3)))
typedef unsigned short bf16;
typedef unsigned v4u __attribute__((ext_vector_type(4)));
typedef unsigned v2u __attribute__((ext_vector_type(2)));
typedef float f32x4 __attribute__((ext_vector_type(4)));
typedef short bf16x8 __attribute__((ext_vector_type(8)));
typedef GAS unsigned gu32;
#define RLX_AGENT __ATOMIC_RELAXED, __HIP_MEMORY_SCOPE_AGENT
#define LDS_WAIT() asm volatile("s_waitcnt lgkmcnt(0)" ::: "memory")
#define VM_WAIT() asm volatile("s_waitcnt vmcnt(0)" ::: "memory")
typedef __bf16 hwbf2_t __attribute__((ext_vector_type(2)));
typedef float hwf2_t __attribute__((ext_vector_type(2)));
__device__ __forceinline__ unsigned f2bf(float f) { return (unsigned)__builtin_bit_cast(unsigned short, (__bf16)f); }
__device__ __forceinline__ unsigned pk2(float lo, float hi) { const hwf2_t v = {lo, hi}; return __builtin_bit_cast(unsigned, __builtin_convertvector(v, hwbf2_t)); }
__device__ __forceinline__ float bf2f(unsigned short b) { return __builtin_bit_cast(float, (unsigned)b << 16); }
__device__ __forceinline__ float bflo(unsigned w) { return __builtin_bit_cast(float, w << 16); }
__device__ __forceinline__ float bfhi(unsigned w) { return __builtin_bit_cast(float, w & 0xffff0000u); }
__device__ __forceinline__ float sigmoidf_(float x) { return __builtin_amdgcn_rcpf(1.f + __builtin_amdgcn_exp2f(x * -1.44269504089f)); }
__device__ __forceinline__ float siluf_(float x) { return x * __builtin_amdgcn_rcpf(1.f + __builtin_amdgcn_exp2f(x * -1.44269504089f)); }
__device__ __forceinline__ float softplusf_(float x) { return x > 20.f ? x : __builtin_amdgcn_logf(1.f + __builtin_amdgcn_exp2f(x * 1.44269504089f)) * 0.69314718056f; }
__device__ __forceinline__ float wave_sum(float v) {
#pragma unroll
    for (int o = 1; o < 64; o <<= 1) v += __shfl_xor(v, o);
    return v;
}
namespace pg8 {
#define PG8_LAS __attribute__((address_space(3)))
typedef unsigned short bf16_t;
typedef short bf16x8 __attribute__((ext_vector_type(8)));
typedef float f32x4 __attribute__((ext_vector_type(4)));
typedef unsigned u32x4 __attribute__((ext_vector_type(4)));
constexpr int BM = 256, BK = 64, HALF = 128, HTB = HALF * BK * 2  , STAGE_BYTES = 8 * HTB, NXCD = 8, WGM = 8;

__host__ __device__ __forceinline__ int lds_byte(int r, int c) { const int st = (r >> 4) * 2 + (c >> 5), rr = r & 15, cc = c & 31, ob = rr * 64 + cc * 2; return st * 1024 + (ob ^ (((ob >> 9) & 1) << 5)); }
__host__ __device__ __forceinline__ void stage_rc(int b, int& R, int& C) { const int st = b / 1024, sb = b % 1024, swz = sb ^ (((sb >> 9) & 1) << 5); R = (st >> 1) * 16 + swz / 64; C = (st & 1) * 32 + (swz % 64) / 2; }
__host__ __device__ __forceinline__ int perm32(int rho) { const int n = rho >> 4, i = rho & 15; return 8 * (i >> 2) + 4 * n + (i & 3); }

struct Unit { int pm, pn; };
struct Gemm { const bf16_t* A; const bf16_t* Bt; int M, N, K; };

struct StaticOrder {
    int nM, nN, nwg, G, c;
    __host__ __device__ void init(int M, int N, int G_, int c_) { nM = M / BM; nN = N / BM; nwg = nM * nN; G = G_; c = c_; }
    __host__ __device__ bool next(int i, Unit& u) const {
        const long L = (long)i * G + c; if (L >= nwg) return false;
        int wgid = (int)L; { const int q = nwg / NXCD, r = nwg % NXCD, xcd = wgid % NXCD, off = wgid / NXCD; wgid = (xcd < r ? xcd * (q + 1) : r * (q + 1) + (xcd - r) * q) + off; }
        const int nig = WGM * nN, gid = wgid / nig, fm = gid * WGM, gsz = (nM - fm) < WGM ? (nM - fm) : WGM;
        u.pm = fm + ((wgid % nig) % gsz); u.pn = (wgid % nig) / gsz; return true;
    }
    __device__ __forceinline__ void a_ready(const Unit&) const {}
    __device__ __forceinline__ void done(const Unit&) const {}
};

__device__ __forceinline__ unsigned cvt_pk_bf16(float lo, float hi) { unsigned r; asm volatile("v_cvt_pk_bf16_f32 %0, %1, %2" : "=v"(r) : "v"(lo), "v"(hi)); return r; }
typedef float f32x2 __attribute__((ext_vector_type(2)));
template <class Epi, class Sched, bool ALIGN_EPI = false, bool SP2 = false>
__device__ __forceinline__ void gemm_phase(PG8_LAS unsigned char* lds, const Gemm g, const Sched& S, const Epi& E) {
    int tid_ = threadIdx.x; asm volatile("" : "+v"(tid_));
    const int tid = tid_, wid = __builtin_amdgcn_readfirstlane(tid >> 6), lane = tid & 63, wr = wid >> 2, wc = wid & 3, fr = lane & 15, fq = lane >> 4;
    const int K = g.K, nt = K / BK;
    unsigned voffA[2], voffB[2];
#pragma unroll
    for (int i = 0; i < 2; ++i) { int R, C; stage_rc(tid * 16 + i * 8192, R, C); const int Rb = Epi::PERM ? ((R & ~31) + perm32(R & 31)) : R;
        voffA[i] = (unsigned)(R * K + C) * 2u; voffB[i] = (unsigned)(Rb * K + C) * 2u; }
    const size_t kstep = (size_t)(BK * 2);
    const size_t hstep = (size_t)HALF * K * 2;
    const size_t tstep = 2 * hstep;
    const unsigned ldsw = (unsigned)wid * 1024u;
    const int aoff = lds_byte(wr * 64 + fr, fq * 8), boff = lds_byte(wc * 32 + fr, fq * 8);
#define PG8_SA(b, h) (((b) * 2 + (h)) * HTB)
#define PG8_SB(b, h) ((4 + (b) * 2 + (h)) * HTB)
#define PG8_STAGE(bufoff, gbase, voff) do { _Pragma("unroll") for (int _i = 0; _i < 2; ++_i) \
        __builtin_amdgcn_global_load_lds((const unsigned*)((const char*)(gbase) + (voff)[_i]), (PG8_LAS unsigned*)(lds + (bufoff) + ldsw + _i * 8192), 16, 0, 0); } while (0)
#define PG8_LDA(dst, b, h) do { _Pragma("unroll") for (int m = 0; m < 4; ++m) _Pragma("unroll") for (int k = 0; k < 2; ++k) dst[m][k] = *(const PG8_LAS bf16x8*)(lds + PG8_SA(b, h) + aoff + m * 2048 + k * 1024); } while (0)
#define PG8_LDB(dst, b, h) do { _Pragma("unroll") for (int n = 0; n < 2; ++n) _Pragma("unroll") for (int k = 0; k < 2; ++k) dst[n][k] = *(const PG8_LAS bf16x8*)(lds + PG8_SB(b, h) + boff + n * 2048 + k * 1024); } while (0)
#define PG8_MMA(ai, bj, At, Bt) do { __builtin_amdgcn_s_setprio(1); _Pragma("unroll") for (int m = 0; m < 4; ++m) _Pragma("unroll") for (int n = 0; n < 2; ++n) _Pragma("unroll") for (int k = 0; k < 2; ++k) \
        acc[ai][bj][m][n] = __builtin_amdgcn_mfma_f32_16x16x32_bf16(Bt[n][k], At[m][k], acc[ai][bj][m][n], 0, 0, 0); __builtin_amdgcn_s_setprio(0); } while (0)
#define PG8_WAIT_V(n) asm volatile("s_waitcnt vmcnt(" #n ")" ::: "memory")
#define PG8_WAIT_L(n) asm volatile("s_waitcnt lgkmcnt(" #n ")" ::: "memory")
#define PG8_BAR __builtin_amdgcn_s_barrier()
#define PG8_SCHED __builtin_amdgcn_sched_barrier(0)
    Unit cur, nxt; int ui = 0;
    if (!S.next(0, cur)) return;
    f32x4 acc[2][2][4][2];
#pragma unroll
    for (int a = 0; a < 2; ++a)
#pragma unroll
        for (int b = 0; b < 2; ++b)
#pragma unroll
            for (int m = 0; m < 4; ++m)
#pragma unroll
                for (int n = 0; n < 2; ++n) acc[a][b][m][n] = (f32x4){0.f, 0.f, 0.f, 0.f};
    bf16x8 At[4][2], B0[2][2], B1[2][2];
    const char* cA = (const char*)g.A + (size_t)cur.pm * tstep; const char* cB = (const char*)g.Bt + (size_t)cur.pn * tstep;
    S.a_ready(cur);
    if constexpr (SP2) {
        PG8_STAGE(PG8_SB(0, 0), cB, voffB); PG8_STAGE(PG8_SB(0, 1), cB + hstep, voffB); PG8_STAGE(PG8_SA(0, 0), cA, voffA); PG8_STAGE(PG8_SA(0, 1), cA + hstep, voffA);
        if (wr == 1) PG8_BAR;
        PG8_WAIT_V(2); PG8_BAR;
        PG8_STAGE(PG8_SB(1, 0), cB + kstep, voffB); PG8_STAGE(PG8_SA(1, 0), cA + kstep, voffA); PG8_STAGE(PG8_SB(1, 1), cB + hstep + kstep, voffB);
        PG8_WAIT_V(6); PG8_BAR;
    } else {
        PG8_STAGE(PG8_SB(0, 0), cB, voffB); PG8_STAGE(PG8_SA(0, 0), cA, voffA); PG8_STAGE(PG8_SB(0, 1), cB + hstep, voffB); PG8_STAGE(PG8_SA(0, 1), cA + hstep, voffA);
        if (wr == 1) PG8_BAR;
        PG8_WAIT_V(4); PG8_BAR;
        PG8_STAGE(PG8_SB(1, 0), cB + kstep, voffB); PG8_STAGE(PG8_SA(1, 0), cA + kstep, voffA); PG8_STAGE(PG8_SB(1, 1), cB + hstep + kstep, voffB);
        PG8_WAIT_V(6); PG8_BAR;
    }
    for (;;) {
        const bool has_next = S.next(ui + 1, nxt);
        const char* nA = has_next ? (const char*)g.A + (size_t)nxt.pm * tstep : cA; const char* nB = has_next ? (const char*)g.Bt + (size_t)nxt.pn * tstep : cB;
        for (int t = 0; t < nt; t += 2) {
            const bool last = (t == nt - 2);
            if constexpr (Epi::MIDK) { if (t == nt / 2) E.midk(acc, cur, wr, wc, fr, fq); }
            const char* a1 = cA + (size_t)(t + 1) * kstep;
            const char* a2 = last ? nA : cA + (size_t)(t + 2) * kstep; const char* b2 = last ? nB : cB + (size_t)(t + 2) * kstep;
            const char* a3 = a2 + kstep; const char* b3 = b2 + kstep;
            if (last && has_next) S.a_ready(nxt);
            if constexpr (SP2) {
            PG8_LDB(B0, 0, 0); PG8_LDB(B1, 0, 1); PG8_SCHED; PG8_LDA(At, 0, 0); PG8_STAGE(PG8_SA(1, 1), a1 + hstep, voffA);
            PG8_WAIT_V(8); PG8_WAIT_L(0); PG8_BAR; PG8_MMA(0, 0, At, B0); PG8_MMA(0, 1, At, B1); PG8_BAR; PG8_SCHED;
            PG8_LDA(At, 0, 1); PG8_STAGE(PG8_SB(0, 0), b2, voffB); PG8_STAGE(PG8_SB(0, 1), b2 + hstep, voffB); PG8_STAGE(PG8_SA(0, 0), a2, voffA);
            PG8_WAIT_V(8); PG8_WAIT_L(0); PG8_BAR; PG8_MMA(1, 0, At, B0); PG8_MMA(1, 1, At, B1); PG8_BAR; PG8_SCHED;
            PG8_LDB(B0, 1, 0); PG8_LDB(B1, 1, 1); PG8_SCHED; PG8_LDA(At, 1, 0); PG8_STAGE(PG8_SA(0, 1), a2 + hstep, voffA);
            PG8_WAIT_V(8); PG8_WAIT_L(0); PG8_BAR; PG8_MMA(0, 0, At, B0); PG8_MMA(0, 1, At, B1); PG8_BAR; PG8_SCHED;
            PG8_LDA(At, 1, 1); PG8_STAGE(PG8_SB(1, 0), b3, voffB); PG8_STAGE(PG8_SB(1, 1), b3 + hstep, voffB); PG8_STAGE(PG8_SA(1, 0), a3, voffA);
            PG8_WAIT_V(8); PG8_WAIT_L(0); PG8_BAR; PG8_MMA(1, 0, At, B0); PG8_MMA(1, 1, At, B1); PG8_BAR; PG8_SCHED;
            } else {
            PG8_LDB(B0, 0, 0); PG8_SCHED; PG8_LDA(At, 0, 0); PG8_STAGE(PG8_SA(1, 1), a1 + hstep, voffA);
            PG8_WAIT_L(8); PG8_BAR; PG8_WAIT_L(0); PG8_MMA(0, 0, At, B0); PG8_BAR; PG8_SCHED;
            PG8_LDB(B1, 0, 1); PG8_STAGE(PG8_SB(0, 0), b2, voffB);
            PG8_BAR; PG8_WAIT_L(0); PG8_MMA(0, 1, At, B1); PG8_BAR;
            PG8_LDA(At, 0, 1); PG8_STAGE(PG8_SA(0, 0), a2, voffA);
            PG8_BAR; PG8_WAIT_L(0); PG8_MMA(1, 0, At, B0); PG8_BAR; PG8_SCHED;
            PG8_STAGE(PG8_SB(0, 1), b2 + hstep, voffB);
            PG8_WAIT_V(6); PG8_BAR; PG8_MMA(1, 1, At, B1); PG8_BAR;
            PG8_LDB(B0, 1, 0); PG8_SCHED; PG8_LDA(At, 1, 0); PG8_STAGE(PG8_SA(0, 1), a2 + hstep, voffA);
            PG8_WAIT_L(8); PG8_BAR; PG8_WAIT_L(0); PG8_MMA(0, 0, At, B0); PG8_BAR; PG8_SCHED;
            PG8_LDB(B1, 1, 1); PG8_STAGE(PG8_SB(1, 0), b3, voffB);
            PG8_BAR; PG8_WAIT_L(0); PG8_MMA(0, 1, At, B1); PG8_BAR;
            PG8_LDA(At, 1, 1); PG8_STAGE(PG8_SA(1, 0), a3, voffA);
            PG8_BAR; PG8_WAIT_L(0); PG8_MMA(1, 0, At, B0); PG8_BAR; PG8_SCHED;
            PG8_STAGE(PG8_SB(1, 1), b3 + hstep, voffB);
            PG8_WAIT_V(6); PG8_BAR; PG8_MMA(1, 1, At, B1); PG8_BAR;
            }
        }
        if constexpr (ALIGN_EPI) { if (wr == 0) PG8_BAR; }
        if constexpr (!Epi::AFTER_DRAIN) { E(acc, cur, wr, wc, fr, fq); S.done(cur); }
        if (!has_next) break;
#pragma unroll
        for (int a = 0; a < 2; ++a)
#pragma unroll
            for (int b = 0; b < 2; ++b)
#pragma unroll
                for (int m = 0; m < 4; ++m)
#pragma unroll
                    for (int n = 0; n < 2; ++n) acc[a][b][m][n] = (f32x4){0.f, 0.f, 0.f, 0.f};
        cur = nxt; cA = nA; cB = nB; ++ui;
        if constexpr (ALIGN_EPI) { if (wr == 1) PG8_BAR; }
    }
    PG8_WAIT_V(0);
    if constexpr (!ALIGN_EPI) { if (wr == 0) PG8_BAR; }
    PG8_BAR;
    if constexpr (Epi::AFTER_DRAIN) { E.fused(acc, cur, wr, wc, fr, fq, lds, wid, lane); S.done(cur); }
#undef PG8_SA
#undef PG8_SB
#undef PG8_STAGE
#undef PG8_LDA
#undef PG8_LDB
#undef PG8_MMA
#undef PG8_WAIT_V
#undef PG8_WAIT_L
#undef PG8_BAR
#undef PG8_SCHED
}
}
#define XB_TMO      128
#define XB_XCNT(j)  (256  + 64 * (j))
#define XB_XSUB(j)  (1280 + 64 * (j))
#define XB_XGEN(j)  (2304 + 64 * (j))
#define XB_TOP      3328
#define XB_TOPGEN   3392
#define XCD_BAR_WORDS 3456
#define XB_SPIN_CAP (1u << 22)

__device__ __forceinline__ unsigned xb_ld(unsigned* p)              { return __hip_atomic_load(p, __ATOMIC_RELAXED, __HIP_MEMORY_SCOPE_AGENT); }
__device__ __forceinline__ unsigned xb_add(unsigned* p, unsigned v) { return __hip_atomic_fetch_add(p, v, __ATOMIC_RELAXED, __HIP_MEMORY_SCOPE_AGENT); }
__device__ __forceinline__ unsigned xb_xcc_id() { return (unsigned)__builtin_amdgcn_s_getreg((3 << 11) | 20) & 0xFu; }
#define XB_SPIN(cond, bar) do { unsigned _sp = 0; while (cond) { __builtin_amdgcn_s_sleep(1); \
    if ((++_sp & 255u) == 0u) { if (xb_ld(&(bar)[XB_TMO])) break; if (_sp > XB_SPIN_CAP) { atomicAdd(&(bar)[XB_TMO], 1u); break; } } } } while (0)

struct XcdBarrier {
    unsigned* bar; unsigned x;
    volatile LAS unsigned* st;
};

__device__ __forceinline__ XcdBarrier xcd_barrier_post(unsigned* bar, volatile LAS unsigned* st) {
    XcdBarrier b; b.bar = bar; b.x = xb_xcc_id(); b.st = st;
    if (threadIdx.x == 0) (void)xb_add(&bar[XB_XCNT(b.x)], 1u);
    return b;
}
__device__ __forceinline__ void xcd_barrier_complete(unsigned* bar, unsigned x, unsigned& nloc, unsigned& nx) {
    const unsigned G = gridDim.x * gridDim.y * gridDim.z;
    unsigned sum, cnt, mine, sp = 0u;
    for (;;) {
        sum = 0u; cnt = 0u; mine = 0u;
#pragma unroll
        for (unsigned j = 0; j < 16; ++j) { const unsigned c = xb_ld(&bar[XB_XCNT(j)]); sum += c; cnt += (c > 0u) ? 1u : 0u; mine = (j == x) ? c : mine; }
        if (sum == G) break;
        __builtin_amdgcn_s_sleep(1);
        if ((++sp & 255u) == 0u) { if (xb_ld(&bar[XB_TMO])) break; if (sp > XB_SPIN_CAP) { atomicAdd(&bar[XB_TMO], 1u); break; } }
    }
    nloc = mine > 0u ? mine : 1u; nx = cnt > 0u ? cnt : 1u;
}

__device__ __forceinline__ void xcd_barrier(const XcdBarrier& b) {
    asm volatile("s_waitcnt vmcnt(0)" ::: "memory");
    __syncthreads();
    if (threadIdx.x == 0) {
        unsigned* bar = b.bar;
        __builtin_amdgcn_s_waitcnt(0);
        unsigned nloc = b.st[0], nx = b.st[1];
        if (nloc == 0u) { xcd_barrier_complete(bar, b.x, nloc, nx); b.st[0] = nloc; b.st[1] = nx; }
        const unsigned old = xb_add(&bar[XB_XSUB(b.x)], 1u);
        const unsigned gen = old / nloc;
        if (old + 1u == (gen + 1u) * nloc) {
            __builtin_amdgcn_fence(__ATOMIC_RELEASE, "agent");
            asm volatile("s_waitcnt vmcnt(0)" ::: "memory");
            const unsigned og = xb_add(&bar[XB_TOP], 1u);
            const unsigned tg = og / nx;
            if (og + 1u == (tg + 1u) * nx) xb_add(&bar[XB_TOPGEN], 1u);
            else XB_SPIN(xb_ld(&bar[XB_TOPGEN]) == tg, bar);
            __builtin_amdgcn_fence(__ATOMIC_ACQUIRE, "agent");
            xb_add(&bar[XB_XGEN(b.x)], 1u);
            asm volatile("s_waitcnt vmcnt(0)" ::: "memory");
        } else {
            XB_SPIN(xb_ld(&bar[XB_XGEN(b.x)]) == gen, bar);
            __builtin_amdgcn_fence(__ATOMIC_ACQUIRE, "agent");
            asm volatile("s_waitcnt vmcnt(0)" ::: "memory");
        }
    }
    __syncthreads();
}
constexpr int NWAVES = 8, NT = 512;
constexpr int D = 1024, NB = 4, SEQ = 8192, CTX = 256;
constexpr int NCTX = NB * CTX;
constexpr int NLAT = NB * SEQ;
constexpr int NROW = NCTX + NLAT;
constexpr int NIN = 11296;
constexpr float EPS = 1e-6f;
constexpr float QSCALE = 0.08838834764831845f;
constexpr int C_QKV = 0, C_GA = 3072, C_AB = 4096, C_QB = 4128, C_GB = 8224, C_MG = 9248;
constexpr int NA = 3328;
constexpr int NPEER = 128;

constexpr size_t MiB = 1u << 20;
constexpr size_t WS_CTL = 0, CTL_ZERO_BYTES = 65536;
constexpr size_t WS_MOD = 65536, WS_LB = 196608, WS_SKB = 262144;
constexpr size_t WS_WTA = 1 * MiB, WS_WTB = 8 * MiB, WS_WTC = 16 * MiB, WS_WTPA = 24 * MiB, WS_WTPB = 26 * MiB, WS_WTO = 28 * MiB, WS_WTQ = 30 * MiB;
constexpr size_t WS_H = 34 * MiB;
constexpr size_t WS_AB = 100 * MiB;
constexpr size_t WS_R1 = 105 * MiB;
constexpr size_t WS_OB = 369 * MiB;
constexpr size_t WS_QKVC = 303 * MiB;
constexpr size_t WS_WTF = 16 * MiB;
__host__ __device__ constexpr size_t ws_eux(int x) { return x < 7 ? (size_t)(1 + 2 * x) * MiB : (size_t)509 * MiB; }
constexpr size_t WS_EV6 = 497 * MiB;
constexpr size_t WS_ESC = 15 * MiB;
constexpr size_t WS_GCB = 501 * MiB;
constexpr size_t WS_END = 511 * MiB;
constexpr int CW_BAR = 1024;

constexpr int RING_BYTES = 131072;
constexpr int LDS_BYTES = 147456;
constexpr int MISC_OFF = LDS_BYTES - 256;

__device__ __forceinline__ const float* late_arg(int i) {
    const __attribute__((address_space(4))) char* kp = (const __attribute__((address_space(4))) char*)__builtin_amdgcn_kernarg_segment_ptr();
    asm volatile("" : "+s"(kp));
    return (const float*)*(const GAS float* const __attribute__((address_space(4)))*)(kp + 8 * i);
}
struct Frame {
    LAS unsigned char* lds;
    int tid, lane, wave, G;
    const float *x, *c, *ctx, *c_ctx, *w_ada, *b_ada, *norm1_w, *w_in, *conv_w, *a_log, *dt_bias, *gdn_norm_w, *lb_logits, *hg_norm_w, *w_pa, *w_pb, *w_o, *norm2_w, *w_query,
        *sub_keys, *expert_u, *expert_v, *final_norm_w;
    float* out; unsigned char* ws;
};

namespace pg8 {
struct EpiStore {
    static constexpr bool PERM = true, AFTER_DRAIN = false, MIDK = false;
    bf16_t* O; int ldc;
    __device__ __forceinline__ void operator()(const f32x4 (&acc)[2][2][4][2], const Unit& u, int wr, int wc, int fr, int fq) const {
        asm volatile("" : "+v"(fr), "+v"(fq));
        const int row0 = u.pm * BM + wr * 64 + fr, col0 = u.pn * BM + wc * 32 + 8 * fq;
#pragma unroll
        for (int ai = 0; ai < 2; ++ai)
#pragma unroll
            for (int m = 0; m < 4; ++m) { bf16_t* rowp = O + (size_t)(row0 + ai * HALF + m * 16) * ldc + col0;
#pragma unroll
                for (int bj = 0; bj < 2; ++bj) { const f32x4 v0 = acc[ai][bj][m][0], v1 = acc[ai][bj][m][1];
                    u32x4 w; w.x = cvt_pk_bf16(v0[0], v0[1]); w.y = cvt_pk_bf16(v0[2], v0[3]); w.z = cvt_pk_bf16(v1[0], v1[1]); w.w = cvt_pk_bf16(v1[2], v1[3]);
                    *(u32x4*)(rowp + bj * HALF) = w; } }
    }
};
struct EpiScoreT {
    static constexpr bool PERM = true, AFTER_DRAIN = false, MIDK = false;
    unsigned short* O;
    __device__ __forceinline__ void operator()(const f32x4 (&acc)[2][2][4][2], const Unit& u, int wr, int wc, int fr, int fq) const {
        asm volatile("" : "+v"(fr), "+v"(fq));
#pragma unroll
        for (int ai = 0; ai < 2; ++ai) {
            const int tb = u.pm * 4 + ai * 2 + wr;
#pragma unroll
            for (int bj = 0; bj < 2; ++bj) {
                unsigned short* bp = O + ((size_t)(tb * 8 + u.pn) * 2 + bj) * 8192 + (wc * 32 + 8 * fq) * 64 + 4 * fr;
#pragma unroll
                for (int n = 0; n < 2; ++n)
#pragma unroll
                    for (int i = 0; i < 4; ++i) {
                        const unsigned lo = (unsigned)__builtin_bit_cast(unsigned short, (_Float16)acc[ai][bj][0][n][i]) | ((unsigned)__builtin_bit_cast(unsigned short, (_Float16)acc[ai][bj][1][n][i]) << 16);
                        const unsigned hi = (unsigned)__builtin_bit_cast(unsigned short, (_Float16)acc[ai][bj][2][n][i]) | ((unsigned)__builtin_bit_cast(unsigned short, (_Float16)acc[ai][bj][3][n][i]) << 16);
                        *(v2u*)(bp + (4 * n + i) * 64) = (v2u){lo, hi}; }
            }
        }
    }
};
struct EpiB {
    static constexpr bool PERM = true, AFTER_DRAIN = false, MIDK = false;
    bf16_t* O; const float* LB;
    __device__ __forceinline__ void operator()(const f32x4 (&acc)[2][2][4][2], const Unit& u, int wr, int wc, int fr, int fq) const {
        asm volatile("" : "+v"(fr), "+v"(fq));
        const int row0 = u.pm * BM + wr * 64 + fr, col0 = u.pn * BM + wc * 32 + 8 * fq;
        const int kind = u.pn < 4 ? 0 : (u.pn < 12 ? 1 : 2);
#pragma unroll
        for (int bj = 0; bj < 2; ++bj) {
            float lb[8];
#pragma unroll
            for (int e = 0; e < 8; ++e) lb[e] = kind == 1 ? LB[(col0 + bj * HALF + e) & 1023] : 0.f;
#pragma unroll
            for (int ai = 0; ai < 2; ++ai)
#pragma unroll
                for (int m = 0; m < 4; ++m) {
                    const int r = row0 + ai * HALF + m * 16; int b, p;
                    if (r < 1024) { b = r >> 8; p = r & 255; } else { const int rr = r - 1024, t = rr & 8191; b = rr >> 13; p = 256 + (t & 63) * 128 + (t >> 6); }
                    const int hh = (u.pn & 3) * 2 + bj, part = u.pn >> 2;
                    bf16_t* rowp = O + ((((size_t)(b * 8 + hh) * 8448 + p) * 4 + part) * 128 + wc * 32 + 8 * fq);
                    float v[8];
#pragma unroll
                    for (int e = 0; e < 4; ++e) { v[e] = acc[ai][bj][m][0][e]; v[4 + e] = acc[ai][bj][m][1][e]; }
                    if (kind == 0) {
#pragma unroll
                        for (int e = 0; e < 8; ++e) v[e] = siluf_(v[e]) * 0.08838834764831845f;
                    } else if (kind == 1) {
#pragma unroll
                        for (int e = 0; e < 8; ++e) v[e] = __builtin_amdgcn_logf(lb[e] + (1.f - lb[e]) * sigmoidf_(v[e]));
                    }
                    u32x4 w; w.x = cvt_pk_bf16(v[0], v[1]); w.y = cvt_pk_bf16(v[2], v[3]); w.z = cvt_pk_bf16(v[4], v[5]); w.w = cvt_pk_bf16(v[6], v[7]);
                    *(u32x4*)rowp = w; }
        }
    }
};
struct EpiC {
    static constexpr bool PERM = true, AFTER_DRAIN = false, MIDK = false;
    bf16_t* G; const bf16_t* OA; bf16_t* OAN; bf16_t* OB; const float* wa; const float* wb; PG8_LAS float* P;
    __device__ __forceinline__ void operator()(const f32x4 (&acc)[2][2][4][2], const Unit& u, int wr, int wc, int fr, int fq) const {
        asm volatile("" : "+v"(fr), "+v"(fq));
        const int row0 = u.pm * BM + wr * 64 + fr;
        if (u.pn >= 8) {
            const int col0 = (u.pn - 8) * BM + wc * 32 + 8 * fq;
#pragma unroll
            for (int ai = 0; ai < 2; ++ai)
#pragma unroll
                for (int m = 0; m < 4; ++m) { bf16_t* rowp = G + (size_t)(row0 + ai * HALF + m * 16) * 2048 + col0;
#pragma unroll
                    for (int bj = 0; bj < 2; ++bj) { const f32x4 v0 = acc[ai][bj][m][0], v1 = acc[ai][bj][m][1];
                        u32x4 w; w.x = cvt_pk_bf16(v0[0], v0[1]); w.y = cvt_pk_bf16(v0[2], v0[3]); w.z = cvt_pk_bf16(v1[0], v1[1]); w.w = cvt_pk_bf16(v1[2], v1[3]);
                        *(u32x4*)(rowp + bj * HALF) = w; } }
            return;
        }
        const bool isB = (u.pn >> 2) != 0; const float* nw = isB ? wb : wa;
        const int col0 = (u.pn & 3) * BM + wc * 32 + 8 * fq;
        const unsigned BWD = 32768u * 1024u;
        const bf16_t* SRC = isB ? (const bf16_t*)OB : OA;
        const unsigned sb0 = isB ? (unsigned)(2 * (u.pn & 3)) * (8192u * 128u) + wc * 32u + 8u * fq : (unsigned)((2 * (u.pn & 3)) * 4 + wc) * (32768u * 32u) + 8u * fq;
        const unsigned sbj = isB ? 8192u * 128u : 4u * 32768u * 32u;
#pragma unroll
        for (int am = 0; am < 4; ++am) { const int ai = am >> 1, mh = am & 1;
            u32x4 f[2][2], b[2][2];
#pragma unroll
            for (int mm = 0; mm < 2; ++mm) { const unsigned grow = (unsigned)(u.pm * BM + ai * HALF + wr * 64 + (2 * mh + mm) * 16 + fr);
                const unsigned tt = grow & 8191u, rofs = isB ? ((grow >> 13) * (8u * 8192u) + (tt & 63u) * 128u + (tt >> 6)) * 128u : grow * 32u;
#pragma unroll
                for (int bj = 0; bj < 2; ++bj) { const bf16_t* sp = SRC + (sb0 + bj * sbj + rofs); f[mm][bj] = *(const u32x4*)sp; b[mm][bj] = *(const u32x4*)(sp + BWD); } }
#pragma unroll
            for (int mm = 0; mm < 2; ++mm) { const int rl = ai * HALF + wr * 64 + (2 * mh + mm) * 16 + fr;
#pragma unroll
                for (int bj = 0; bj < 2; ++bj) { float ss = 0.f;
#pragma unroll
                    for (int e = 0; e < 4; ++e) { const float x0 = bflo(f[mm][bj][e]) + bflo(b[mm][bj][e]), x1 = bfhi(f[mm][bj][e]) + bfhi(b[mm][bj][e]); ss += x0 * x0 + x1 * x1; }
                    ss += __shfl_xor(ss, 16); ss += __shfl_xor(ss, 32);
                    if (fq == 0) P[(rl * 2 + bj) * 4 + wc] = ss; } }
            asm volatile("" ::: "memory");
        }
        asm volatile("s_waitcnt lgkmcnt(0)" ::: "memory"); __builtin_amdgcn_s_barrier(); asm volatile("" ::: "memory");
#pragma unroll
        for (int am = 0; am < 4; ++am) { const int ai = am >> 1, mh = am & 1;
            u32x4 f[2][2], b[2][2];
#pragma unroll
            for (int mm = 0; mm < 2; ++mm) { const unsigned grow = (unsigned)(u.pm * BM + ai * HALF + wr * 64 + (2 * mh + mm) * 16 + fr);
                const unsigned tt = grow & 8191u, rofs = isB ? ((grow >> 13) * (8u * 8192u) + (tt & 63u) * 128u + (tt >> 6)) * 128u : grow * 32u;
#pragma unroll
                for (int bj = 0; bj < 2; ++bj) { const bf16_t* sp = SRC + (sb0 + bj * sbj + rofs); f[mm][bj] = *(const u32x4*)sp; b[mm][bj] = *(const u32x4*)(sp + BWD); } }
            const f32x4 wlo = *(const f32x4*)(nw + wc * 32 + 8 * fq), whi = *(const f32x4*)(nw + wc * 32 + 8 * fq + 4);
            const float w8[8] = {wlo[0], wlo[1], wlo[2], wlo[3], whi[0], whi[1], whi[2], whi[3]};
#pragma unroll
            for (int mm = 0; mm < 2; ++mm) { const int m = 2 * mh + mm, rl = ai * HALF + wr * 64 + m * 16 + fr; const unsigned grow = (unsigned)(u.pm * BM + rl);
#pragma unroll
                for (int bj = 0; bj < 2; ++bj) {
                    bf16_t* dp = OAN + ((isB ? 32768u * 1024u : 0u) + grow * 1024u + col0 + bj * HALF);
                    const f32x4 pp = *(const PG8_LAS f32x4*)(P + (rl * 2 + bj) * 4);
                    const float r = rsqrtf(((pp[0] + pp[1]) + (pp[2] + pp[3])) * (1.f / 128.f) + 1e-6f);
                    const f32x4 g0 = acc[ai][bj][m][0], g1 = acc[ai][bj][m][1];
                    float y[8];
#pragma unroll
                    for (int e = 0; e < 4; ++e) { const float gl = e < 2 ? g0[2 * e] : g1[2 * e - 4], gh = e < 2 ? g0[2 * e + 1] : g1[2 * e - 3];
                        y[2 * e] = (bflo(f[mm][bj][e]) + bflo(b[mm][bj][e])) * r * w8[2 * e] * siluf_(gl); y[2 * e + 1] = (bfhi(f[mm][bj][e]) + bfhi(b[mm][bj][e])) * r * w8[2 * e + 1] * siluf_(gh); }
                    u32x4 w; w.x = cvt_pk_bf16(y[0], y[1]); w.y = cvt_pk_bf16(y[2], y[3]); w.z = cvt_pk_bf16(y[4], y[5]); w.w = cvt_pk_bf16(y[6], y[7]);
                    *(u32x4*)dp = w; } }
            asm volatile("" ::: "memory");
        }
    }
};
struct EpiA {
    static constexpr bool PERM = true, AFTER_DRAIN = false, MIDK = false;
    bf16_t* O; float* AB; const float* a_log; const float* dt_bias;
    __device__ __forceinline__ void operator()(const f32x4 (&acc)[2][2][4][2], const Unit& u, int wr, int wc, int fr, int fq) const {
        asm volatile("" : "+v"(fr), "+v"(fq));
        const int row0 = u.pm * BM + wr * 64 + fr;
        if (u.pn < 12) {
            const int col0 = u.pn * BM + wc * 32 + 8 * fq;
#pragma unroll
            for (int ai = 0; ai < 2; ++ai)
#pragma unroll
                for (int m = 0; m < 4; ++m) { bf16_t* rowp = O + (size_t)(row0 + ai * HALF + m * 16) * 3072 + col0;
#pragma unroll
                    for (int bj = 0; bj < 2; ++bj) { const f32x4 v0 = acc[ai][bj][m][0], v1 = acc[ai][bj][m][1];
                        u32x4 w; w.x = cvt_pk_bf16(v0[0], v0[1]); w.y = cvt_pk_bf16(v0[2], v0[3]); w.z = cvt_pk_bf16(v1[0], v1[1]); w.w = cvt_pk_bf16(v1[2], v1[3]);
                        *(u32x4*)(rowp + bj * HALF) = w; } }
        } else if (wc == 0) {
            float al[8], db[8];
#pragma unroll
            for (int hh = 0; hh < 8; ++hh) { al[hh] = fq < 2 ? __expf(a_log[fq * 8 + hh]) : 0.f; db[hh] = fq < 2 ? dt_bias[fq * 8 + hh] : 0.f; }
#pragma unroll
            for (int ai = 0; ai < 2; ++ai)
#pragma unroll
                for (int m = 0; m < 4; ++m) { float* rowp = AB + (size_t)(row0 + ai * HALF + m * 16) * 32 + 8 * fq;
#pragma unroll
                    for (int n = 0; n < 2; ++n) { const f32x4 v = acc[ai][0][m][n]; f32x4 o;
#pragma unroll
                        for (int i = 0; i < 4; ++i) o[i] = fq < 2 ? -al[4 * n + i] * softplusf_(v[i] + db[4 * n + i]) : sigmoidf_(v[i]);
                        *(f32x4*)(rowp + 4 * n) = o; } }
        }
    }
};
struct EpiGate {
    static constexpr bool PERM = true, AFTER_DRAIN = false, MIDK = false;
    bf16_t* O; const bf16_t* G; int goff; const bf16_t* ADD;
    __device__ __forceinline__ void operator()(const f32x4 (&acc)[2][2][4][2], const Unit& u, int wr, int wc, int fr, int fq) const {
        asm volatile("" : "+v"(fr), "+v"(fq));
        const int row0 = u.pm * BM + wr * 64 + fr, col0 = u.pn * BM + wc * 32 + 8 * fq;
#pragma unroll
        for (int ai = 0; ai < 2; ++ai) {
            u32x4 g[4][2], a[4][2];
#pragma unroll
            for (int m = 0; m < 4; ++m)
#pragma unroll
                for (int bj = 0; bj < 2; ++bj) { const size_t row = (size_t)(row0 + ai * HALF + m * 16); const int col = col0 + bj * HALF;
                    g[m][bj] = *(const u32x4*)(G + row * 2048 + goff + col);
                    a[m][bj] = ADD ? *(const u32x4*)(ADD + row * 1024 + col) : (u32x4){0u, 0u, 0u, 0u}; }
#pragma unroll
            for (int m = 0; m < 4; ++m)
#pragma unroll
                for (int bj = 0; bj < 2; ++bj) { const size_t row = (size_t)(row0 + ai * HALF + m * 16); const int col = col0 + bj * HALF;
                    const u32x4 gg = g[m][bj], aa = a[m][bj];
                    const f32x4 v0 = acc[ai][bj][m][0], v1 = acc[ai][bj][m][1];
                    float r[8];
                    r[0] = sigmoidf_(bflo(gg.x)) * v0[0] + bflo(aa.x); r[1] = sigmoidf_(bfhi(gg.x)) * v0[1] + bfhi(aa.x);
                    r[2] = sigmoidf_(bflo(gg.y)) * v0[2] + bflo(aa.y); r[3] = sigmoidf_(bfhi(gg.y)) * v0[3] + bfhi(aa.y);
                    r[4] = sigmoidf_(bflo(gg.z)) * v1[0] + bflo(aa.z); r[5] = sigmoidf_(bfhi(gg.z)) * v1[1] + bfhi(aa.z);
                    r[6] = sigmoidf_(bflo(gg.w)) * v1[2] + bflo(aa.w); r[7] = sigmoidf_(bfhi(gg.w)) * v1[3] + bfhi(aa.w);
                    u32x4 w; w.x = cvt_pk_bf16(r[0], r[1]); w.y = cvt_pk_bf16(r[2], r[3]); w.z = cvt_pk_bf16(r[4], r[5]); w.w = cvt_pk_bf16(r[6], r[7]);
                    *(u32x4*)(O + row * 1024 + col) = w; }
            asm volatile("" ::: "memory");
        }
    }
};
struct EpiResid {
    static constexpr bool PERM = true, AFTER_DRAIN = false, MIDK = false;
    bf16_t* O; const float* X; const float* MOD;
    __device__ __forceinline__ void operator()(const f32x4 (&acc)[2][2][4][2], const Unit& u, int wr, int wc, int fr, int fq) const {
        asm volatile("" : "+v"(fr), "+v"(fq));
        const int row0 = u.pm * BM + wr * 64 + fr, col0 = u.pn * BM + wc * 32 + 8 * fq;
        const float* g1 = MOD + (size_t)((u.pm * BM) >> 13) * 6144 + 2048;
        f32x4 gv[2][2];
#pragma unroll
        for (int bj = 0; bj < 2; ++bj) { gv[bj][0] = *(const f32x4*)(g1 + col0 + bj * HALF); gv[bj][1] = *(const f32x4*)(g1 + col0 + bj * HALF + 4); }
#pragma unroll
        for (int ai = 0; ai < 2; ++ai)
#pragma unroll
            for (int mh = 0; mh < 2; ++mh) {
                f32x4 xv[2][2][2];
#pragma unroll
                for (int mm = 0; mm < 2; ++mm)
#pragma unroll
                    for (int bj = 0; bj < 2; ++bj) { const size_t off = (size_t)(row0 + ai * HALF + (2 * mh + mm) * 16) * 1024 + col0 + bj * HALF;
                        xv[mm][bj][0] = *(const f32x4*)(X + off); xv[mm][bj][1] = *(const f32x4*)(X + off + 4); }
#pragma unroll
                for (int mm = 0; mm < 2; ++mm)
#pragma unroll
                    for (int bj = 0; bj < 2; ++bj) { const int m = 2 * mh + mm; const size_t off = (size_t)(row0 + ai * HALF + m * 16) * 1024 + col0 + bj * HALF;
                        const f32x4 y0 = xv[mm][bj][0] + gv[bj][0] * acc[ai][bj][m][0], y1 = xv[mm][bj][1] + gv[bj][1] * acc[ai][bj][m][1];
                        *(u32x4*)(O + off) = (u32x4){cvt_pk_bf16(y0[0], y0[1]), cvt_pk_bf16(y0[2], y0[3]), cvt_pk_bf16(y1[0], y1[1]), cvt_pk_bf16(y1[2], y1[3])}; }
                asm volatile("" ::: "memory");
            }
    }
};
struct EpiMerge {
    static constexpr bool PERM = true, AFTER_DRAIN = false, MIDK = true;
    bf16_t* O; const bf16_t* G;
    __device__ __forceinline__ void midk(f32x4 (&acc)[2][2][4][2], const Unit& u, int wr, int wc, int fr, int fq) const {
        asm volatile("" : "+v"(fr), "+v"(fq));
        const int row0 = u.pm * BM + wr * 64 + fr, col0 = u.pn * BM + wc * 32 + 8 * fq;
#pragma unroll
        for (int ai = 0; ai < 2; ++ai) {
            u32x4 ga[4][2], gb[4][2];
#pragma unroll
            for (int m = 0; m < 4; ++m)
#pragma unroll
                for (int bj = 0; bj < 2; ++bj) { const bf16_t* gp = G + (size_t)(row0 + ai * HALF + m * 16) * 2048 + col0 + bj * HALF; ga[m][bj] = *(const u32x4*)gp; gb[m][bj] = *(const u32x4*)(gp + 1024); }
#pragma unroll
            for (int m = 0; m < 4; ++m)
#pragma unroll
                for (int bj = 0; bj < 2; ++bj)
#pragma unroll
                    for (int e = 0; e < 4; ++e) {
                        const float ea0 = __builtin_amdgcn_exp2f(bflo(ga[m][bj][e]) * -1.44269504089f), ea1 = __builtin_amdgcn_exp2f(bfhi(ga[m][bj][e]) * -1.44269504089f);
                        const float eb0 = __builtin_amdgcn_exp2f(fminf(bflo(gb[m][bj][e]) * -1.44269504089f, 60.f)), eb1 = __builtin_amdgcn_exp2f(fminf(bfhi(gb[m][bj][e]) * -1.44269504089f, 60.f));
                        const float r0 = (1.f + eb0) * __builtin_amdgcn_rcpf(1.f + ea0), r1 = (1.f + eb1) * __builtin_amdgcn_rcpf(1.f + ea1);
                        if (e < 2) { acc[ai][bj][m][0][2 * e] *= r0; acc[ai][bj][m][0][2 * e + 1] *= r1; } else { acc[ai][bj][m][1][2 * e - 4] *= r0; acc[ai][bj][m][1][2 * e - 3] *= r1; }
                    }
            asm volatile("" ::: "memory");
        }
    }
    __device__ __forceinline__ void operator()(const f32x4 (&acc)[2][2][4][2], const Unit& u, int wr, int wc, int fr, int fq) const {
        asm volatile("" : "+v"(fr), "+v"(fq));
        const int row0 = u.pm * BM + wr * 64 + fr, col0 = u.pn * BM + wc * 32 + 8 * fq;
#pragma unroll
        for (int ai = 0; ai < 2; ++ai) {
            u32x4 g[4][2];
#pragma unroll
            for (int m = 0; m < 4; ++m)
#pragma unroll
                for (int bj = 0; bj < 2; ++bj) g[m][bj] = *(const u32x4*)(G + (size_t)(row0 + ai * HALF + m * 16) * 2048 + 1024 + col0 + bj * HALF);
#pragma unroll
            for (int m = 0; m < 4; ++m)
#pragma unroll
                for (int bj = 0; bj < 2; ++bj) { const u32x4 gg = g[m][bj]; const f32x4 v0 = acc[ai][bj][m][0], v1 = acc[ai][bj][m][1];
                    u32x4 w; w.x = cvt_pk_bf16(sigmoidf_(bflo(gg.x)) * v0[0], sigmoidf_(bfhi(gg.x)) * v0[1]); w.y = cvt_pk_bf16(sigmoidf_(bflo(gg.y)) * v0[2], sigmoidf_(bfhi(gg.y)) * v0[3]);
                    w.z = cvt_pk_bf16(sigmoidf_(bflo(gg.z)) * v1[0], sigmoidf_(bfhi(gg.z)) * v1[1]); w.w = cvt_pk_bf16(sigmoidf_(bflo(gg.w)) * v1[2], sigmoidf_(bfhi(gg.w)) * v1[3]);
                    *(u32x4*)(O + (size_t)(row0 + ai * HALF + m * 16) * 1024 + col0 + bj * HALF) = w; }
            asm volatile("" ::: "memory");
        }
    }
};
}

__device__ __forceinline__ void p0_transpose_item(const float* W, int pitch, int ncols, int K, bf16* WT, LAS float* scr, int item, int lane, int ldk = 0) {
    if (ldk == 0) ldk = K;
    const int nblk = ncols / 32, kb = item / nblk, nb = item % nblk, k0 = 64 * kb, n0 = 32 * nb;
#pragma unroll 8
    for (int i = 0; i < 32; ++i) { const int kk = 2 * i + (lane >> 5); scr[kk * 33 + (lane & 31)] = W[(size_t)(k0 + kk) * pitch + n0 + (lane & 31)]; }
    LDS_WAIT(); asm volatile("" ::: "memory");
    const int c = lane & 7;
#pragma unroll
    for (int j = 0; j < 4; ++j) { const int n = (lane >> 3) + 8 * j; const LAS float* s = scr + (8 * c) * 33 + n;
        v4u o; o.x = pk2(s[0 * 33], s[1 * 33]); o.y = pk2(s[2 * 33], s[3 * 33]); o.z = pk2(s[4 * 33], s[5 * 33]); o.w = pk2(s[6 * 33], s[7 * 33]);
        *(v4u*)(WT + (size_t)(n0 + n) * ldk + k0 + 8 * c) = o; }
    LDS_WAIT(); asm volatile("" ::: "memory");
}
__device__ __forceinline__ void p0_prologue(Frame& F) {
    {
        LAS float* sc = (LAS float*)F.lds;
        LAS float* red = (LAS float*)(F.lds + 32768);
        if ((int)blockIdx.x < 96) {
            for (int i = F.tid; i < 5120; i += NT) { const int r = i >> 10, k = i & 1023; const float v = r < 4 ? F.c[r * 1024 + k] : F.c_ctx[k]; sc[i] = siluf_(v); }
            __syncthreads();
            float* MOD = (float*)(F.ws + WS_MOD);
            for (int grp = blockIdx.x; grp < 96; grp += F.G) {
                const int col = grp * 64 + F.lane, ks = F.wave;
                float acc[5] = {0.f, 0.f, 0.f, 0.f, 0.f};
                for (int k = ks * 128; k < ks * 128 + 128; ++k) { const float w = F.w_ada[(size_t)k * 6144 + col];
#pragma unroll
                    for (int r = 0; r < 5; ++r) acc[r] = fmaf(sc[r * 1024 + k], w, acc[r]); }
#pragma unroll
                for (int r = 0; r < 5; ++r) red[(ks * 5 + r) * 64 + F.lane] = acc[r];
                __syncthreads();
                if (F.tid < 320) { const int r = F.tid >> 6; float s = 0.f;
#pragma unroll
                    for (int q = 0; q < 8; ++q) s += red[(q * 5 + r) * 64 + F.lane];
                    MOD[r * 6144 + col] = s + F.b_ada[col]; }
                __syncthreads();
            }
        }
        if (blockIdx.x == 96) { float* LB = (float*)(F.ws + WS_LB); for (int i = F.tid; i < 1024; i += NT) LB[i] = sigmoidf_(F.lb_logits[i] - F.lb_logits[1024 + i]); }
    }
    LAS float* scr = (LAS float*)(F.lds + 49152 + F.wave * 8448);
    const int gw = blockIdx.x * NWAVES + F.wave, NGW = F.G * NWAVES;
    bf16* WTA = (bf16*)(F.ws + WS_WTA); bf16* WTB = (bf16*)(F.ws + WS_WTB); bf16* WTC = (bf16*)(F.ws + WS_WTC);
    constexpr int I0 = 16 * 96, I1 = 16 * 1, I2 = 16 * 128, I3 = 16 * 32, I4 = 16 * 32, I5 = 16 * 64, I6 = 16 * 32, I7 = 16 * 32, I8 = 16 * 32, I9 = 16 * 64;
    constexpr int NITEMS = I0 + I1 + I2 + I3 + I4 + I5 + I6 + I7 + I8 + I9;
    for (int it = gw; it < I0 + I1 + I2; it += NGW) {
        int r = it;
        if (r < I0) { p0_transpose_item(F.w_in + C_QKV, NIN, 3072, D, WTA, scr, r, F.lane); continue; } r -= I0;
        if (r < I1) { p0_transpose_item(F.w_in + C_AB, NIN, 32, D, WTA + (size_t)3072 * D, scr, r, F.lane); continue; } r -= I1;
        p0_transpose_item(F.w_in + C_QB, NIN, 4096, D, WTB, scr, r, F.lane);
    }
    { v4u* z = (v4u*)(WTA + (size_t)3104 * D); for (int i = blockIdx.x * NT + F.tid; i < 28672; i += F.G * NT) z[i] = (v4u){0u, 0u, 0u, 0u}; }
}

__device__ __forceinline__ void norm_mod_row_bf16(const float* src, const float* w, const float* shift, const float* scale, bf16* dst, int lane) {
    const f32x4* xr = (const f32x4*)src + lane; f32x4 v[4]; float s = 0.f;
#pragma unroll
    for (int j = 0; j < 4; ++j) { v[j] = xr[64 * j]; s += (v[j].x * v[j].x + v[j].y * v[j].y) + (v[j].z * v[j].z + v[j].w * v[j].w); }
    const float r = rsqrtf(wave_sum(s) * (1.f / D) + EPS);
    unsigned long long* o8 = (unsigned long long*)dst + lane;
#pragma unroll
    for (int j = 0; j < 4; ++j) { const f32x4 ww = ((const f32x4*)w)[64 * j + lane], sh = ((const f32x4*)shift)[64 * j + lane], sc = ((const f32x4*)scale)[64 * j + lane];
        const f32x4 y = v[j] * r * ww * (sc + 1.f) + sh;
        o8[64 * j] = (unsigned long long)pk2(y.x, y.y) | ((unsigned long long)pk2(y.z, y.w) << 32); }
}
__device__ __forceinline__ void p1_h(Frame& F) {
    const int gw = blockIdx.x * NWAVES + F.wave, NGW = F.G * NWAVES;
    const float* MOD = (const float*)(F.ws + WS_MOD); bf16* H = (bf16*)(F.ws + WS_H);
    for (int r = gw; r < NROW; r += NGW) {
        const float* src; const float* md;
        if (r < NCTX) { src = F.ctx + (size_t)r * D; md = MOD + 4 * 6144; } else { src = F.x + (size_t)(r - NCTX) * D; md = MOD + (size_t)((r - NCTX) >> 13) * 6144; }
        norm_mod_row_bf16(src, F.norm1_w, md, md + 1024, H + (size_t)r * D, F.lane);
    }
}

typedef short s16x4 __attribute__((ext_vector_type(4)));
__device__ __forceinline__ bf16x8 ld_row(const LAS unsigned char* img, int pitch, int r0, int k0, int lane) {
    return *(const LAS bf16x8*)(img + (r0 + (lane & 15)) * pitch + (k0 + 8 * (lane >> 4)) * 2);
}
__device__ __forceinline__ bf16x8 ld_tr(const LAS unsigned char* img, int pitch, int k0, int n0, int lane) {
    const int g = lane >> 4, q = (lane >> 2) & 3, p = lane & 3;
    const LAS unsigned char* a0 = img + (k0 + 8 * g + q) * pitch + (n0 + 4 * p) * 2;
    const s16x4 lo = __builtin_amdgcn_ds_read_tr16_b64_v4i16((LAS s16x4*)a0);
    const s16x4 hi = __builtin_amdgcn_ds_read_tr16_b64_v4i16((LAS s16x4*)(a0 + 4 * pitch));
    bf16x8 r; r[0] = lo[0]; r[1] = lo[1]; r[2] = lo[2]; r[3] = lo[3]; r[4] = hi[0]; r[5] = hi[1]; r[6] = hi[2]; r[7] = hi[3];
    return r;
}
#define MFMA16(a, b, c) __builtin_amdgcn_mfma_f32_16x16x32_bf16((a), (b), (c), 0, 0, 0)


#define LDS_BARRIER() do { asm volatile("s_waitcnt lgkmcnt(0)" ::: "memory"); __builtin_amdgcn_s_barrier(); asm volatile("" ::: "memory"); } while (0)
__device__ __forceinline__ void p2b_gdn_prep(Frame& F) {
    const bf16* QKV = (const bf16*)(F.ws + WS_R1); bf16* QKVC = (bf16*)(F.ws + WS_QKVC); const float* conv_w = late_arg(8);
    const int gw = blockIdx.x * NWAVES + F.wave, NGW = F.G * NWAVES, lane = F.lane;
    for (int item = gw; item < (NROW / 64) * 6; item += NGW) {
        const int rb = item / 6, c6 = item - rb * 6, row0 = rb * 64, ch0 = c6 * 512 + lane * 8;
        int seg0, seg1;
        if (row0 < NCTX) { seg0 = row0 & ~(CTX - 1); seg1 = seg0 + CTX; } else { seg0 = NCTX + ((row0 - NCTX) & ~(SEQ - 1)); seg1 = seg0 + SEQ; }
        float cw[3][8];
#pragma unroll
        for (int j = 0; j < 3; ++j) { const f32x4 a = *(const f32x4*)(conv_w + j * 3072 + ch0), b = *(const f32x4*)(conv_w + j * 3072 + ch0 + 4);
            cw[j][0] = a.x; cw[j][1] = a.y; cw[j][2] = a.z; cw[j][3] = a.w; cw[j][4] = b.x; cw[j][5] = b.y; cw[j][6] = b.z; cw[j][7] = b.w; }
        const v4u zero4 = (v4u){0u, 0u, 0u, 0u};
        const float nscale = c6 < 2 ? QSCALE : 1.f;
        v4u win[10];
        win[0] = row0 > seg0 ? *(const v4u*)(QKV + (size_t)(row0 - 1) * 3072 + ch0) : zero4;
        win[1] = *(const v4u*)(QKV + (size_t)row0 * 3072 + ch0);
        for (int g = 0; g < 8; ++g) {
#pragma unroll
            for (int e = 0; e < 8; ++e) { const int row = row0 + 8 * g + e + 1; win[2 + e] = row < seg1 ? *(const v4u*)(QKV + (size_t)row * 3072 + ch0) : zero4; }
#pragma unroll
            for (int rr = 0; rr < 8; ++rr) {
                const int row = row0 + 8 * g + rr;
                const v4u prev = win[rr], cur = win[rr + 1], nxt = win[rr + 2];
                float y[8]; float ss = 0.f;
#pragma unroll
                for (int e = 0; e < 4; ++e) {
                    const unsigned pw = prev[e], cwd = cur[e], nw = nxt[e];
                    const float a0 = cw[0][2 * e] * bflo(pw) + cw[1][2 * e] * bflo(cwd) + cw[2][2 * e] * bflo(nw);
                    const float a1 = cw[0][2 * e + 1] * bfhi(pw) + cw[1][2 * e + 1] * bfhi(cwd) + cw[2][2 * e + 1] * bfhi(nw);
                    y[2 * e] = siluf_(a0); y[2 * e + 1] = siluf_(a1);
                    ss += y[2 * e] * y[2 * e] + y[2 * e + 1] * y[2 * e + 1];
                }
                float sc = 1.f;
                if (c6 < 4) {
                    ss += __shfl_xor(ss, 1); ss += __shfl_xor(ss, 2); ss += __shfl_xor(ss, 4); ss += __shfl_xor(ss, 8);
                    sc = rsqrtf(ss + EPS) * nscale;
                }
                v4u o; o.x = pk2(y[0] * sc, y[1] * sc); o.y = pk2(y[2] * sc, y[3] * sc); o.z = pk2(y[4] * sc, y[5] * sc); o.w = pk2(y[6] * sc, y[7] * sc);
                { int bb, tp; if (row < NCTX) { bb = row >> 8; tp = row & 255; } else { const int rr = row - NCTX; bb = rr >> 13; tp = 256 + (rr & 8191); }
                  const int part = ch0 >> 10, hd = (ch0 >> 7) & 7, cc = ch0 & 127;
                  *(v4u*)(QKVC + ((((size_t)(bb * 8 + hd) * 8448 + tp) * 3 + part) * 128 + cc)) = o; }
            }
            win[0] = win[8]; win[1] = win[9];
        }
    }
}

__device__ __forceinline__ size_t gdn_row(int b, int dir, int ci, int i) {
    const int seg = ci < 4 ? 0 : 1, cs = seg == 0 ? ci : ci - 4, nch = seg == 0 ? 4 : 128, lo = (dir == 0 ? cs : nch - 1 - cs) * 64;
    return (seg == 0 ? (size_t)b * CTX : (size_t)NCTX + (size_t)b * SEQ) + (dir == 0 ? lo + i : lo + 63 - i);
}
__device__ __forceinline__ int gdn_pos(int dir, int ci, int i) {
    const int seg = ci < 4 ? 0 : 1, cs = seg == 0 ? ci : ci - 4, nch = seg == 0 ? 4 : 128, lo = (dir == 0 ? cs : nch - 1 - cs) * 64;
    return seg * 256 + (dir == 0 ? lo + i : lo + 63 - i);
}
__device__ __forceinline__ void p3a_gdn_tw(Frame& F) {
    constexpr int PK = 272, PP = 144;
    constexpr int GRP_BYTES = 2 * 64 * PK + 3 * 64 * PP + 4096 + 512;
    const int tid = F.tid, lane = F.lane, w = F.wave, fr = lane & 15, fq = lane >> 4;
    const int g = w >> 2, wl = w & 3, tg = tid & 255;
    LAS unsigned char* base = F.lds + g * GRP_BYTES;
    LAS unsigned char* Kb = base;
    LAS unsigned char* KBG = Kb + 64 * PK;
    LAS unsigned char* Wn = Kb;
    LAS unsigned char* Mb = KBG + 64 * PK;
    LAS unsigned char* Tm = Mb + 64 * PP;
    LAS unsigned char* TMP = Tm + 64 * PP;
    LAS float* Md = (LAS float*)(TMP + 64 * PP);
    LAS float* gcs = Md + 1024;
    LAS float* bet = gcs + 64;
    const bf16* QKVC = (const bf16*)(F.ws + WS_QKVC); const float* AB = (const float*)(F.ws + WS_AB);
    unsigned char* TW = F.ws + WS_R1;
    const int li = tg >> 2, seg4 = tg & 3;
    __syncthreads();
    for (int i = tg; i < 64 * PP / 4; i += 256) ((LAS unsigned*)TMP)[i] = 0u;
    v4u k0, k1, k2, k3; float gi = 0.f, bi = 0.f;
#define TW_LOAD(cp_) do { const int ch_ = (cp_) / 132, ci_ = (cp_) - ch_ * 132, b_ = ch_ >> 4, h_ = (ch_ >> 1) & 7, dir_ = ch_ & 1; \
        { const bf16* rp_ = QKVC + (((size_t)(b_ * 8 + h_) * 8448 + gdn_pos(dir_, ci_, li)) * 3 + 1) * 128 + seg4 * 32; k0 = *(const v4u*)rp_; k1 = *(const v4u*)(rp_ + 8); k2 = *(const v4u*)(rp_ + 16); k3 = *(const v4u*)(rp_ + 24); } \
        if (wl == 0) { const size_t row_ = gdn_row(b_, dir_, ci_, lane); gi = AB[row_ * 32 + dir_ * 8 + h_]; bi = AB[row_ * 32 + 16 + dir_ * 8 + h_]; } } while (0)
    constexpr int NPAIR = 8448 / 2;
    if ((int)blockIdx.x < NPAIR) TW_LOAD(2 * (int)blockIdx.x + g);
    for (int pr = blockIdx.x; pr < NPAIR; pr += F.G) {
        const int cp = 2 * pr + g;
        if (wl == 0) {
            float x = gi;
#pragma unroll
            for (int o = 1; o < 64; o <<= 1) { const float y = __shfl_up(x, o); if (lane >= o) x += y; }
            gcs[lane] = x; bet[lane] = bi;
        }
        for (int i = tg; i < 64 * PP / 16; i += 256) ((LAS v4u*)Tm)[i] = (v4u){0u, 0u, 0u, 0u};
        __syncthreads();
        {
            const float fac = bet[li] * __expf(gcs[li]);
            const int o = li * PK + seg4 * 64;
            *(LAS v4u*)(Kb + o) = k0; *(LAS v4u*)(Kb + o + 16) = k1; *(LAS v4u*)(Kb + o + 32) = k2; *(LAS v4u*)(Kb + o + 48) = k3;
#define SC4(k_) ((v4u){pk2(bflo(k_.x) * fac, bfhi(k_.x) * fac), pk2(bflo(k_.y) * fac, bfhi(k_.y) * fac), pk2(bflo(k_.z) * fac, bfhi(k_.z) * fac), pk2(bflo(k_.w) * fac, bfhi(k_.w) * fac)})
            *(LAS v4u*)(KBG + o) = SC4(k0); *(LAS v4u*)(KBG + o + 16) = SC4(k1); *(LAS v4u*)(KBG + o + 32) = SC4(k2); *(LAS v4u*)(KBG + o + 48) = SC4(k3);
#undef SC4
        }
        __syncthreads();
        if (pr + F.G < NPAIR) TW_LOAD(2 * (pr + F.G) + g);
#pragma unroll
        for (int q = 0; q < 3; ++q) {
            const int tq = wl + 4 * q;
            if (tq < 10) {
                const int it = tq < 4 ? 3 : tq < 7 ? 2 : tq < 9 ? 1 : 0, jt = tq < 4 ? tq : tq < 7 ? tq - 4 : tq < 9 ? tq - 7 : 0;
                f32x4 accK = (f32x4){0.f, 0.f, 0.f, 0.f};
#pragma unroll
                for (int ks = 0; ks < 4; ++ks) accK = MFMA16(ld_row(Kb, PK, it * 16, ks * 32, lane), ld_row(Kb, PK, jt * 16, ks * 32, lane), accK);
                const float gj = gcs[jt * 16 + fr];
#pragma unroll
                for (int r = 0; r < 4; ++r) {
                    const int il = 4 * fq + r;
                    const float gr = gcs[it * 16 + il], br = bet[it * 16 + il];
                    const bool lower = jt < it || il > fr;
                    const float m = lower ? br * accK[r] * __expf(gr - gj) : 0.f;
                    *(LAS unsigned short*)(Mb + (it * 16 + il) * PP + (jt * 16 + fr) * 2) = (unsigned short)f2bf(m);
                    if (jt == it) Md[(it * 16 + il) * 16 + fr] = m;
                }
            }
        }
        __syncthreads();
        if (wl == 0) {
            const int bk = lane >> 4, c = lane & 15;
            float x[16];
#pragma unroll
            for (int r = 0; r < 16; ++r) x[r] = r == c ? 1.f : 0.f;
#pragma unroll
            for (int m = 0; m < 15; ++m) {
#pragma unroll
                for (int r = m + 1; r < 16; ++r) x[r] = fmaf(-Md[(bk * 16 + r) * 16 + m], x[m], x[r]);
            }
#pragma unroll
            for (int r = 0; r < 16; ++r) *(LAS unsigned short*)(Tm + (bk * 16 + r) * PP + (bk * 16 + c) * 2) = (unsigned short)f2bf(x[r]);
        }
        __syncthreads();
        if (wl < 2) {
            const int o32 = 32 * wl;
            const f32x4 acc = MFMA16(ld_row(Mb, PP, o32 + 16, o32, lane), ld_tr(Tm, PP, o32, o32, lane), ((f32x4){0.f, 0.f, 0.f, 0.f}));
#pragma unroll
            for (int r = 0; r < 4; ++r) *(LAS unsigned short*)(TMP + (o32 + 16 + 4 * fq + r) * PP + (o32 + fr) * 2) = (unsigned short)f2bf(acc[r]);
        }
        __syncthreads();
        if (wl < 2) {
            const int o32 = 32 * wl;
            const f32x4 acc = MFMA16(ld_row(Tm, PP, o32 + 16, o32, lane), ld_tr(TMP, PP, o32, o32, lane), ((f32x4){0.f, 0.f, 0.f, 0.f}));
#pragma unroll
            for (int r = 0; r < 4; ++r) *(LAS unsigned short*)(Tm + (o32 + 16 + 4 * fq + r) * PP + (o32 + fr) * 2) = (unsigned short)f2bf(-acc[r]);
        }
        __syncthreads();
        {
            const int yi = wl >> 1, yj = wl & 1;
            const f32x4 acc = MFMA16(ld_row(Mb, PP, 32 + 16 * yi, 0, lane), ld_tr(Tm, PP, 0, 16 * yj, lane), ((f32x4){0.f, 0.f, 0.f, 0.f}));
#pragma unroll
            for (int r = 0; r < 4; ++r) *(LAS unsigned short*)(TMP + (32 + 16 * yi + 4 * fq + r) * PP + (16 * yj + fr) * 2) = (unsigned short)f2bf(acc[r]);
        }
        __syncthreads();
        {
            const int yi = wl >> 1, yj = wl & 1;
            const f32x4 acc = MFMA16(ld_row(Tm, PP, 32 + 16 * yi, 32, lane), ld_tr(TMP, PP, 32, 16 * yj, lane), ((f32x4){0.f, 0.f, 0.f, 0.f}));
#pragma unroll
            for (int r = 0; r < 4; ++r) *(LAS unsigned short*)(Tm + (32 + 16 * yi + 4 * fq + r) * PP + (16 * yj + fr) * 2) = (unsigned short)f2bf(-acc[r]);
        }
        __syncthreads();
        {
            const int it = wl;
            bf16x8 at[2];
            at[0] = ld_row(Tm, PP, it * 16, 0, lane); at[1] = ld_row(Tm, PP, it * 16, 32, lane);
            const int nks = it >= 2 ? 2 : 1;
#pragma unroll
            for (int dt = 0; dt < 8; ++dt) {
                f32x4 acc = (f32x4){0.f, 0.f, 0.f, 0.f};
#pragma unroll
                for (int ks = 0; ks < 2; ++ks) if (ks < nks) acc = MFMA16(at[ks], ld_tr(KBG, PK, ks * 32, dt * 16, lane), acc);
#pragma unroll
                for (int r = 0; r < 4; ++r) *(LAS unsigned short*)(Wn + (it * 16 + 4 * fq + r) * PK + (dt * 16 + fr) * 2) = (unsigned short)f2bf(-acc[r]);
            }
        }
        __syncthreads();
        {
            if (tg < 128) ((float*)(F.ws + WS_GCB))[(size_t)cp * 128 + tg] = gcs[tg];
            unsigned char* dst = TW + (size_t)cp * 24576;
            *(v4u*)(dst + li * 128 + seg4 * 32) = *(const LAS v4u*)(Tm + li * PP + seg4 * 32);
            *(v4u*)(dst + li * 128 + seg4 * 32 + 16) = *(const LAS v4u*)(Tm + li * PP + seg4 * 32 + 16);
#pragma unroll
            for (int q = 0; q < 4; ++q) *(v4u*)(dst + 8192 + li * 256 + seg4 * 64 + 16 * q) = *(const LAS v4u*)(Wn + li * PK + seg4 * 64 + 16 * q);
        }
        __syncthreads();
    }
#undef TW_LOAD
}

struct GdnCtx { LAS unsigned char *Kb, *Qb, *Wn, *VB, *Tm, *QKd, *St, *Vt, *Vst; LAS float *gcs, *bet; const bf16* QKVC; const float* GCB; const unsigned char* TW; bf16* OA; bf16* JUNK;
                int lane, w, fr, fq, li, seg8, it, half, b, h, dir, sl, chain; };
struct GdnRegs { v4u q0, q1, k0, k1, t0, w0, w1; v2u vv; float gi, bi; };
__device__ __forceinline__ void gdn_load(const GdnCtx& C, GdnRegs& R, int ci) {
    const bf16* rp = C.QKVC + ((size_t)(C.b * 8 + C.h) * 8448 + gdn_pos(C.dir, ci, C.li)) * 384 + C.seg8 * 16;
    R.q0 = *(const v4u*)rp; R.q1 = *(const v4u*)(rp + 8); R.k0 = *(const v4u*)(rp + 128); R.k1 = *(const v4u*)(rp + 136);
    R.vv = *(const v2u*)(rp + 256 - C.seg8 * 16 + C.sl * 32 + C.seg8 * 4);
    const unsigned char* src = C.TW + (size_t)(C.chain * 132 + ci) * 24576;
    R.t0 = *(const v4u*)(src + C.li * 128 + C.seg8 * 16); R.w0 = *(const v4u*)(src + 8192 + C.li * 256 + C.seg8 * 32); R.w1 = *(const v4u*)(src + 8192 + C.li * 256 + C.seg8 * 32 + 16);
    { const float* gp = C.GCB + (size_t)(C.chain * 132 + ci) * 128; R.bi = gp[64 + C.li]; R.gi = gp[(C.w & 1) * 64 + C.lane]; }
}
__device__ __forceinline__ void gdn_chunk(const GdnCtx& C, GdnRegs& R, f32x4 (&Sacc)[2], int ci) {
    constexpr int PK = 272, PP = 144, PV = 80;
    const int lane = C.lane, w = C.w, fr = C.fr, fq = C.fq, li = C.li, seg8 = C.seg8, it = C.it, half = C.half;
    const int seg = ci < 4 ? 0 : 1, cs = seg == 0 ? ci : ci - 4, nch = seg == 0 ? 4 : 128, lo = (C.dir == 0 ? cs : nch - 1 - cs) * 64;
    if (w < 2) C.gcs[w * 64 + lane] = R.gi;
    {
        const int o = li * PK + seg8 * 32;
        *(LAS v4u*)(C.Qb + o) = R.q0; *(LAS v4u*)(C.Qb + o + 16) = R.q1;
        *(LAS v4u*)(C.Kb + o) = R.k0; *(LAS v4u*)(C.Kb + o + 16) = R.k1;
        *(LAS v4u*)(C.Wn + o) = R.w0; *(LAS v4u*)(C.Wn + o + 16) = R.w1;
        *(LAS v4u*)(C.Tm + li * PP + seg8 * 16) = R.t0;
        const float bti = R.bi;
        *(LAS v2u*)(C.VB + li * PV + seg8 * 8) = (v2u){pk2(bflo(R.vv.x) * bti, bfhi(R.vv.x) * bti), pk2(bflo(R.vv.y) * bti, bfhi(R.vv.y) * bti)};
    }
    LDS_BARRIER();
    gdn_load(C, R, ci + 2 < 132 ? ci + 2 : 131);
    f32x4 acc_o = (f32x4){0.f, 0.f, 0.f, 0.f}, acc_v = acc_o;
    {
        bf16x8 aq[4], kb[2][4], tm[2], vb[2], bs[4], wn[4];
        float gr[4], gj[2];
#pragma unroll
        for (int ks = 0; ks < 4; ++ks) aq[ks] = ld_row(C.Qb, PK, it * 16, ks * 32, lane);
#pragma unroll
        for (int jj = 0; jj < 2; ++jj)
#pragma unroll
            for (int ks = 0; ks < 4; ++ks) kb[jj][ks] = ld_row(C.Kb, PK, (2 * half + jj) * 16, ks * 32, lane);
#pragma unroll
        for (int ks = 0; ks < 2; ++ks) { tm[ks] = ld_row(C.Tm, PP, it * 16, ks * 32, lane); vb[ks] = ld_tr(C.VB, PV, ks * 32, half * 16, lane); }
#pragma unroll
        for (int ks = 0; ks < 4; ++ks) { bs[ks] = ld_row(C.St, PK, half * 16, ks * 32, lane); wn[ks] = ld_row(C.Wn, PK, it * 16, ks * 32, lane); }
#pragma unroll
        for (int r = 0; r < 4; ++r) gr[r] = C.gcs[it * 16 + 4 * fq + r];
        gj[0] = C.gcs[(2 * half) * 16 + fr]; gj[1] = C.gcs[(2 * half + 1) * 16 + fr];
        const float gl = C.gcs[63];
        __builtin_amdgcn_sched_barrier(0);
#pragma unroll
        for (int jj = 0; jj < 2; ++jj) {
            const int jt = 2 * half + jj;
            f32x4 accQ = (f32x4){0.f, 0.f, 0.f, 0.f};
            if (jt <= it) {
#pragma unroll
                for (int ks = 0; ks < 4; ++ks) accQ = MFMA16(aq[ks], kb[jj][ks], accQ);
            }
#pragma unroll
            for (int r = 0; r < 4; ++r) {
                const int il = 4 * fq + r;
                const bool lowereq = jt < it || (jt == it && il >= fr);
                const float qk = lowereq ? accQ[r] * __expf(gr[r] - gj[jj]) : 0.f;
                *(LAS unsigned short*)(C.QKd + (it * 16 + il) * PP + (jt * 16 + fr) * 2) = (unsigned short)f2bf(qk);
            }
        }
        const int nks = it >= 2 ? 2 : 1;
#pragma unroll
        for (int ks = 0; ks < 2; ++ks) if (ks < nks) acc_v = MFMA16(tm[ks], vb[ks], acc_v);
#pragma unroll
        for (int ks = 0; ks < 4; ++ks) { acc_v = MFMA16(wn[ks], bs[ks], acc_v); acc_o = MFMA16(aq[ks], bs[ks], acc_o); }
        float sv[4];
#pragma unroll
        for (int r = 0; r < 4; ++r) { acc_o[r] *= __expf(gr[r]); sv[r] = acc_v[r] * __expf(gl - gr[r]); }
        const int o = (half * 16 + fr) * PP + (it * 16 + 4 * fq) * 2;
        *(LAS v2u*)(C.Vt + o) = (v2u){pk2(acc_v[0], acc_v[1]), pk2(acc_v[2], acc_v[3])};
        *(LAS v2u*)(C.Vst + o) = (v2u){pk2(sv[0], sv[1]), pk2(sv[2], sv[3])};
    }
    LDS_BARRIER();
    {
        const int d0 = 16 * w;
        bf16x8 qd[2], vt[2], kt[2], vs[2][2];
#pragma unroll
        for (int ks = 0; ks < 2; ++ks) { qd[ks] = ld_row(C.QKd, PP, it * 16, ks * 32, lane); vt[ks] = ld_row(C.Vt, PP, half * 16, ks * 32, lane); kt[ks] = ld_tr(C.Kb, PK, ks * 32, d0, lane); }
#pragma unroll
        for (int ct = 0; ct < 2; ++ct)
#pragma unroll
            for (int ks = 0; ks < 2; ++ks) vs[ct][ks] = ld_row(C.Vst, PP, ct * 16, ks * 32, lane);
        const float egl = __expf(C.gcs[63]);
        __builtin_amdgcn_sched_barrier(0);
#pragma unroll
        for (int ks = 0; ks < 2; ++ks) if (2 * ks <= it) acc_o = MFMA16(qd[ks], vt[ks], acc_o);
        {
#pragma unroll
            for (int r = 0; r < 4; ++r) { const int i = it * 16 + 4 * fq + r, t = C.dir == 0 ? lo + i : lo + 63 - i;
                bf16* op = seg == 1 ? C.OA + ((((size_t)C.dir * 8 + C.h) * 4 + C.sl) * NLAT + (size_t)C.b * SEQ + t) * 32 + half * 16 + fr
                                    : C.JUNK + r;
                *op = (bf16)f2bf(acc_o[r]); }
        }
#pragma unroll
        for (int ct = 0; ct < 2; ++ct) {
#pragma unroll
            for (int r = 0; r < 4; ++r) Sacc[ct][r] *= egl;
#pragma unroll
            for (int ks = 0; ks < 2; ++ks) Sacc[ct] = MFMA16(kt[ks], vs[ct][ks], Sacc[ct]);
            *(LAS v2u*)(C.St + (ct * 16 + fr) * PK + (d0 + 4 * fq) * 2) = (v2u){pk2(Sacc[ct][0], Sacc[ct][1]), pk2(Sacc[ct][2], Sacc[ct][3])};
        }
    }
    LDS_BARRIER();
}
__device__ __forceinline__ void p3_gdn_chunk(Frame& F, bf16* OA) {
    constexpr int PK = 272, PP = 144, PV = 80;
    GdnCtx C;
    C.Kb = F.lds; C.Qb = C.Kb + 64 * PK; C.Wn = C.Qb + 64 * PK; C.VB = C.Wn + 64 * PK; C.Tm = C.VB + 64 * PV; C.QKd = C.Tm + 64 * PP; C.St = C.QKd + 64 * PP;
    C.Vt = C.St + 32 * PK; C.Vst = C.Vt + 32 * PP; C.gcs = (LAS float*)(C.Vst + 32 * PP); C.bet = C.gcs + 64;
    C.QKVC = (const bf16*)(F.ws + WS_QKVC); C.GCB = (const float*)(F.ws + WS_GCB); C.TW = F.ws + WS_R1; C.OA = OA; C.JUNK = (bf16*)(F.ws + WS_AB) + (blockIdx.x * NT + F.tid) * 8;
    C.lane = F.lane; C.w = F.wave; C.fr = F.lane & 15; C.fq = F.lane >> 4; C.li = F.tid >> 3; C.seg8 = F.tid & 7; C.it = F.wave >> 1; C.half = F.wave & 1;
    for (int item = blockIdx.x; item < 256; item += F.G) {
        const int xcd = item & 7, idx = item >> 3;
        C.chain = xcd * 8 + (idx >> 2); C.sl = idx & 3; C.b = C.chain >> 4; C.h = (C.chain >> 1) & 7; C.dir = C.chain & 1;
        f32x4 Sacc[2]; Sacc[0] = (f32x4){0.f, 0.f, 0.f, 0.f}; Sacc[1] = Sacc[0];
        __syncthreads();
        for (int i = F.tid; i < 32 * PK / 4; i += NT) ((LAS unsigned*)C.St)[i] = 0u;
        GdnRegs R0, R1;
        R0.gi = R0.bi = R1.gi = R1.bi = 0.f;
        gdn_load(C, R0, 0); gdn_load(C, R1, 1);
        for (int ci = 0; ci < 132; ci += 2) { gdn_chunk(C, R0, Sacc, ci); gdn_chunk(C, R1, Sacc, ci + 1); }
    }
}
typedef float f32x2v __attribute__((ext_vector_type(2)));
#define F2V(a, b) ((f32x2v){(a), (b)})
template <bool B> struct HgTag { static constexpr bool value = B; };
constexpr int HG_SPLIT = 76;
__device__ __forceinline__ void p5_hg_chunk(Frame& F, bf16* OB) {
    constexpr int PK = 272, PP = 144;
    LAS unsigned char* Qd = F.lds;
    LAS unsigned char* Kinv = Qd + 64 * PK;
    LAS unsigned char* Vv = Kinv + 64 * PK;
    LAS unsigned char* St = Vv + 64 * PP;
    LAS unsigned char* Pm = St + 64 * PK;
    LAS float* totd = (LAS float*)(Pm + 64 * PP);
    LAS float* tot8 = totd + 128;
    LAS float* tot8b = tot8 + 1024;
    LAS float* totdb = tot8b + 1024;
    const bf16* QFI = (const bf16*)(F.ws + WS_R1);
    bf16* JUNK = (bf16*)(F.ws + WS_AB);
    const int tid = F.tid, lane = F.lane, w = F.wave, fr = lane & 15, fq = lane >> 4;
    const int dp = lane, rg = w;
    const int vr = tid >> 3, vs = (tid & 7) * 8;
    const int it = w >> 1, half = w & 1;
    for (int item = blockIdx.x; item < 256; item += F.G) {
        const int part = item >> 7, base = item & 127;
        const int xcd = base & 7, idx = base >> 3, chain = xcd * 8 + (idx >> 1), sl = idx & 1;
        const int b = chain >> 4, h = (chain >> 1) & 7, dir = chain & 1;
        f32x4 Sacc[4];
#pragma unroll
        for (int ct = 0; ct < 4; ++ct) Sacc[ct] = (f32x4){0.f, 0.f, 0.f, 0.f};
        __syncthreads();
        for (int i = tid; i < 64 * PK / 4; i += NT) ((LAS unsigned*)St)[i] = 0u;
        unsigned qA[8], fA[8], qB[8], fB[8]; v4u vA, vB;
#define HG_LOAD(ci) do { \
            const int seg_ = (ci) < 4 ? 0 : 1, cs_ = seg_ == 0 ? (ci) : (ci) - 4, nch_ = seg_ == 0 ? 4 : 128, lo_ = (dir == 0 ? cs_ : nch_ - 1 - cs_) * 64 + seg_ * 256; \
            const bf16* cb_ = QFI + ((size_t)(b * 8 + h) * 8448 + lo_) * 512;     \
            _Pragma("unroll") for (int il = 0; il < 8; ++il) { const int i_ = rg * 8 + il; const bf16* rp_ = cb_ + (dir == 0 ? i_ : 63 - i_) * 512 + 2 * dp; \
                qraw[il] = *(const unsigned*)rp_; fraw[il] = *(const unsigned*)(rp_ + 128 + dir * 128); } \
            vraw = *(const v4u*)(cb_ + (dir == 0 ? vr : 63 - vr) * 512 + 384 + sl * 64 + vs); } while (0)
        auto chunk = [&](auto tag, const int ci, unsigned (&qraw)[8], unsigned (&fraw)[8], v4u& vraw) __attribute__((always_inline)) {
            constexpr bool FULL = decltype(tag)::value;
            const int seg = ci < 4 ? 0 : 1, cs = seg == 0 ? ci : ci - 4, nch = seg == 0 ? 4 : 128, lo = (dir == 0 ? cs : nch - 1 - cs) * 64;
            float f0[8], f1[8], p0[8], p1[8]; float r0 = 1.f, r1 = 1.f;
#pragma unroll
            for (int il = 0; il < 8; ++il) { f0[il] = __builtin_amdgcn_exp2f(bflo(fraw[il])); f1[il] = __builtin_amdgcn_exp2f(bfhi(fraw[il])); r0 *= f0[il]; r1 *= f1[il]; p0[il] = r0; p1[il] = r1; }
            *(LAS f32x2v*)(tot8 + rg * 128 + 2 * dp) = F2V(r0, r1);
            *(LAS v4u*)(Vv + vr * PP + vs * 2) = vraw;
            LDS_BARRIER();
            {
                float o0 = 1.f, o1 = 1.f, a0 = 1.f, a1 = 1.f;
#pragma unroll
                for (int g = 0; g < 8; ++g) { const f32x2v t = *(const LAS f32x2v*)(tot8 + g * 128 + 2 * dp); if (g < rg) { o0 *= t.x; o1 *= t.y; } a0 *= t.x; a1 *= t.y; }
                if (rg == 0) *(LAS f32x2v*)(totd + 2 * dp) = F2V(a0, a1);
                float n0 = __builtin_amdgcn_rcpf(p0[7] * o0), n1 = __builtin_amdgcn_rcpf(p1[7] * o1);
#pragma unroll
                for (int il = 7; il >= 0; --il) {
                    const float e0 = p0[il] * o0, e1 = p1[il] * o1;
                    const int o = (rg * 8 + il) * PK + dp * 4;
                    if constexpr (FULL) *(LAS unsigned*)(Qd + o) = pk2(bflo(qraw[il]) * e0, bfhi(qraw[il]) * e1);
                    *(LAS unsigned*)(Kinv + o) = pk2((1.f - f0[il]) * n0, (1.f - f1[il]) * n1);
                    n0 *= f0[il]; n1 *= f1[il];
                }
            }
            LDS_BARRIER();
            HG_LOAD(ci + 2 < 132 ? ci + 2 : 131);
            f32x4 acc_o[2];
            if constexpr (FULL) {
                bf16x8 aq[4], bs[2][4], bk[2][4];
#pragma unroll
                for (int ks = 0; ks < 4; ++ks) aq[ks] = ld_row(Qd, PK, it * 16, ks * 32, lane);
#pragma unroll
                for (int cc = 0; cc < 2; ++cc)
#pragma unroll
                    for (int ks = 0; ks < 4; ++ks) bs[cc][ks] = ld_row(St, PK, (2 * half + cc) * 16, ks * 32, lane);
                __builtin_amdgcn_sched_barrier(0);
#pragma unroll
                for (int jj = 0; jj < 2; ++jj)
#pragma unroll
                    for (int ks = 0; ks < 4; ++ks) bk[jj][ks] = ld_row(Kinv, PK, (2 * half + jj) * 16, ks * 32, lane);
#pragma unroll
                for (int cc = 0; cc < 2; ++cc) { acc_o[cc] = (f32x4){0.f, 0.f, 0.f, 0.f};
#pragma unroll
                    for (int ks = 0; ks < 4; ++ks) acc_o[cc] = MFMA16(aq[ks], bs[cc][ks], acc_o[cc]); }
                __builtin_amdgcn_sched_barrier(0);
#pragma unroll
                for (int jj = 0; jj < 2; ++jj) {
                    const int jt = 2 * half + jj;
                    f32x4 acc_s = (f32x4){0.f, 0.f, 0.f, 0.f};
                    if (jt <= it) {
#pragma unroll
                        for (int ks = 0; ks < 4; ++ks) acc_s = MFMA16(aq[ks], bk[jj][ks], acc_s);
                    }
#pragma unroll
                    for (int r = 0; r < 4; ++r) {
                        float v = acc_s[r];
                        if (jt == it && (4 * fq + r) < fr) v = 0.f;
                        *(LAS unsigned short*)(Pm + (it * 16 + 4 * fq + r) * PP + (jt * 16 + fr) * 2) = (unsigned short)f2bf(v);
                    }
                }
                LDS_BARRIER();
            }
            {
                const int nks = it >= 2 ? 2 : 1, d0 = 16 * w;
                bf16x8 ap[2], bv[2][2], ak[2], vv[4][2]; float td[4];
                if constexpr (FULL) {
                    ap[0] = ld_row(Pm, PP, it * 16, 0, lane); ap[1] = ld_row(Pm, PP, it * 16, 32, lane);
#pragma unroll
                    for (int cc = 0; cc < 2; ++cc)
#pragma unroll
                        for (int ks = 0; ks < 2; ++ks) bv[cc][ks] = ld_tr(Vv, PP, ks * 32, (2 * half + cc) * 16, lane);
                }
                ak[0] = ld_tr(Kinv, PK, 0, d0, lane); ak[1] = ld_tr(Kinv, PK, 32, d0, lane);
#pragma unroll
                for (int ct = 0; ct < 4; ++ct)
#pragma unroll
                    for (int ks = 0; ks < 2; ++ks) vv[ct][ks] = ld_tr(Vv, PP, ks * 32, ct * 16, lane);
#pragma unroll
                for (int r = 0; r < 4; ++r) td[r] = totd[d0 + 4 * fq + r];
                __builtin_amdgcn_sched_barrier(0);
                if constexpr (FULL) {
#pragma unroll
                for (int cc = 0; cc < 2; ++cc) {
#pragma unroll
                    for (int ks = 0; ks < 2; ++ks) if (ks < nks) acc_o[cc] = MFMA16(ap[ks], bv[cc][ks], acc_o[cc]);
                }
                {
#pragma unroll
                    for (int r = 0; r < 4; ++r) { const int i = it * 16 + 4 * fq + r, p = dir == 0 ? lo + i : lo + 63 - i;
                        bf16* op = seg == 1 ? OB + ((((size_t)dir * 4 + b) * 8 + h) * SEQ + p) * 128 + sl * 64 + 32 * half + fr
                                            : JUNK + ((blockIdx.x & 127) * NT + tid) * 32 + r;
                        op[0] = (bf16)f2bf(acc_o[0][r]); op[16] = (bf16)f2bf(acc_o[1][r]); }
                }
                }
#pragma unroll
                for (int ct = 0; ct < 4; ++ct) {
                    f32x4 acc = Sacc[ct];
#pragma unroll
                    for (int ks = 0; ks < 2; ++ks) acc = MFMA16(ak[ks], vv[ct][ks], acc);
#pragma unroll
                    for (int r = 0; r < 4; ++r) Sacc[ct][r] = acc[r] * td[r];
                    *(LAS v2u*)(St + (ct * 16 + fr) * PK + (d0 + 4 * fq) * 2) = (v2u){pk2(Sacc[ct][0], Sacc[ct][1]), pk2(Sacc[ct][2], Sacc[ct][3])};
                }
            }
            LDS_BARRIER();
        };
        auto state2 = [&](const int ci, unsigned (&q1)[8], unsigned (&f1r)[8], v4u& v1, unsigned (&q2)[8], unsigned (&f2r)[8], v4u& v2) __attribute__((always_inline)) {
            LAS unsigned char* KinvB = Qd; LAS unsigned char* VvB = Pm;
            float fa0[8], fa1[8], fb0[8], fb1[8], ea0, ea1, eb0, eb1;
            {
                float r0 = 1.f, r1 = 1.f;
#pragma unroll
                for (int il = 0; il < 8; ++il) { fa0[il] = __builtin_amdgcn_exp2f(bflo(f1r[il])); fa1[il] = __builtin_amdgcn_exp2f(bfhi(f1r[il])); r0 *= fa0[il]; r1 *= fa1[il]; }
                ea0 = r0; ea1 = r1;
                *(LAS f32x2v*)(tot8 + rg * 128 + 2 * dp) = F2V(r0, r1);
                *(LAS v4u*)(Vv + vr * PP + vs * 2) = v1;
                r0 = 1.f; r1 = 1.f;
#pragma unroll
                for (int il = 0; il < 8; ++il) { fb0[il] = __builtin_amdgcn_exp2f(bflo(f2r[il])); fb1[il] = __builtin_amdgcn_exp2f(bfhi(f2r[il])); r0 *= fb0[il]; r1 *= fb1[il]; }
                eb0 = r0; eb1 = r1;
                *(LAS f32x2v*)(tot8b + rg * 128 + 2 * dp) = F2V(r0, r1);
                *(LAS v4u*)(VvB + vr * PP + vs * 2) = v2;
            }
            LDS_BARRIER();
#define HG_KINV(T8, TD, KI, F0, F1, E0, E1) do { float o0 = 1.f, o1 = 1.f, a0 = 1.f, a1 = 1.f; \
                _Pragma("unroll") for (int g = 0; g < 8; ++g) { const f32x2v t = *(const LAS f32x2v*)(T8 + g * 128 + 2 * dp); if (g < rg) { o0 *= t.x; o1 *= t.y; } a0 *= t.x; a1 *= t.y; } \
                if (rg == 0) *(LAS f32x2v*)(TD + 2 * dp) = F2V(a0, a1); \
                float n0 = __builtin_amdgcn_rcpf(E0 * o0), n1 = __builtin_amdgcn_rcpf(E1 * o1); \
                _Pragma("unroll") for (int il = 7; il >= 0; --il) { *(LAS unsigned*)(KI + (rg * 8 + il) * PK + dp * 4) = pk2((1.f - F0[il]) * n0, (1.f - F1[il]) * n1); n0 *= F0[il]; n1 *= F1[il]; } } while (0)
            HG_KINV(tot8, totd, Kinv, fa0, fa1, ea0, ea1);
            HG_KINV(tot8b, totdb, KinvB, fb0, fb1, eb0, eb1);
#undef HG_KINV
            LDS_BARRIER();
            { const int c1 = ci + 4 < 132 ? ci + 4 : 131, c2 = ci + 5 < 132 ? ci + 5 : 131;
              { unsigned (&qraw)[8] = q1; unsigned (&fraw)[8] = f1r; v4u& vraw = v1; HG_LOAD(c1); }
              { unsigned (&qraw)[8] = q2; unsigned (&fraw)[8] = f2r; v4u& vraw = v2; HG_LOAD(c2); } }
            {
                const int d0 = 16 * w;
                bf16x8 ak[2], vv[4][2]; float td[4];
#pragma unroll
                for (int cc = 0; cc < 2; ++cc) {
                    LAS unsigned char* KI = cc == 0 ? Kinv : KinvB; LAS unsigned char* VI = cc == 0 ? Vv : VvB; LAS float* TD = cc == 0 ? totd : totdb;
                    ak[0] = ld_tr(KI, PK, 0, d0, lane); ak[1] = ld_tr(KI, PK, 32, d0, lane);
#pragma unroll
                    for (int ct = 0; ct < 4; ++ct)
#pragma unroll
                        for (int ks = 0; ks < 2; ++ks) vv[ct][ks] = ld_tr(VI, PP, ks * 32, ct * 16, lane);
#pragma unroll
                    for (int r = 0; r < 4; ++r) td[r] = TD[d0 + 4 * fq + r];
                    __builtin_amdgcn_sched_barrier(0);
#pragma unroll
                    for (int ct = 0; ct < 4; ++ct) {
                        f32x4 acc = Sacc[ct];
#pragma unroll
                        for (int ks = 0; ks < 2; ++ks) acc = MFMA16(ak[ks], vv[ct][ks], acc);
#pragma unroll
                        for (int r = 0; r < 4; ++r) Sacc[ct][r] = acc[r] * td[r];
                        if (cc == 1) *(LAS v2u*)(St + (ct * 16 + fr) * PK + (d0 + 4 * fq) * 2) = (v2u){pk2(Sacc[ct][0], Sacc[ct][1]), pk2(Sacc[ct][2], Sacc[ct][3])};
                    }
                    __builtin_amdgcn_sched_barrier(0);
                }
            }
            LDS_BARRIER();
        };
        { unsigned (&qraw)[8] = qA; unsigned (&fraw)[8] = fA; v4u& vraw = vA; HG_LOAD(0); }
        { unsigned (&qraw)[8] = qB; unsigned (&fraw)[8] = fB; v4u& vraw = vB; HG_LOAD(1); }
        if (part == 0) {
            for (int ci = 0; ci < HG_SPLIT; ci += 2) { chunk(HgTag<true>{}, ci, qA, fA, vA); chunk(HgTag<true>{}, ci + 1, qB, fB, vB); }
        } else {
            unsigned qC[8], fC[8], qD[8], fD[8]; v4u vC, vD;
            { unsigned (&qraw)[8] = qC; unsigned (&fraw)[8] = fC; v4u& vraw = vC; HG_LOAD(2); }
            { unsigned (&qraw)[8] = qD; unsigned (&fraw)[8] = fD; v4u& vraw = vD; HG_LOAD(3); }
            for (int ci = 0; ci < HG_SPLIT; ci += 4) { state2(ci, qA, fA, vA, qB, fB, vB); state2(ci + 2, qC, fC, vC, qD, fD, vD); }
            for (int ci = HG_SPLIT; ci < 132; ci += 2) { chunk(HgTag<true>{}, ci, qA, fA, vA); chunk(HgTag<true>{}, ci + 1, qB, fB, vB); }
        }
#undef HG_LOAD
    }
}
typedef unsigned v6u __attribute__((ext_vector_type(6)));
typedef unsigned v3u __attribute__((ext_vector_type(3)));
typedef v3u v3u_a4 __attribute__((aligned(4)));
typedef v4u v4u_a8 __attribute__((aligned(8)));
typedef float v32f __attribute__((ext_vector_type(32)));
typedef __bf16 v32bf __attribute__((ext_vector_type(32)));
__device__ __forceinline__ void side_work(Frame& F, int sid, int nside) {
    const float* w_in = late_arg(7); const float* w_pa = late_arg(14); const float* w_pb = late_arg(15); const float* w_o = late_arg(16); const float* w_query = late_arg(18);
    const float* sub_keys = late_arg(19); const float* expert_u = late_arg(20); const float* expert_v = late_arg(21);
    const int gw = sid * NWAVES + F.wave, NGW = nside * NWAVES;
    {
        LAS float* scr = (LAS float*)(F.lds + 49152 + F.wave * 8448);
        bf16* WTC = (bf16*)(F.ws + WS_WTC);
        constexpr int J3 = 16 * 32, J4 = 16 * 32, J5 = 16 * 64, J6 = 16 * 32, J7 = 16 * 32, J8 = 16 * 32, J9 = 16 * 64;
        for (int it = gw; it < J3 + J4 + J5 + J6 + J7 + J8 + J9; it += NGW) {
            int r = it;
        if (r < J3) { p0_transpose_item(w_in + C_GA, NIN, 1024, D, WTC, scr, r, F.lane); continue; } r -= J3;
        if (r < J4) { p0_transpose_item(w_in + C_GB, NIN, 1024, D, WTC + (size_t)1024 * D, scr, r, F.lane); continue; } r -= J4;
        if (r < J5) { p0_transpose_item(w_in + C_MG, NIN, 2048, D, WTC + (size_t)2048 * D, scr, r, F.lane); continue; } r -= J5;
        if (r < J6) { p0_transpose_item(w_pa, 1024, 1024, D, (bf16*)(F.ws + WS_WTPA), scr, r, F.lane); continue; } r -= J6;
        if (r < J7) { p0_transpose_item(w_pb, 1024, 1024, D, (bf16*)(F.ws + WS_WTPA) + (size_t)1024 * D, scr, r, F.lane); continue; } r -= J7;
        if (r < J8) { p0_transpose_item(w_o, 1024, 1024, D, (bf16*)(F.ws + WS_WTO), scr, r, F.lane); continue; } r -= J8;
        p0_transpose_item(w_query, 2048, 2048, D, (bf16*)(F.ws + WS_WTQ), scr, r, F.lane);
        }
    }
    { const f32x4* sk = (const f32x4*)sub_keys; v2u* o = (v2u*)(F.ws + WS_SKB);
      for (int i = sid * NT + F.tid; i < 65536; i += nside * NT) { const f32x4 v = sk[i]; o[i] = (v2u){pk2(v.x, v.y), pk2(v.z, v.w)}; } }
    for (int row0 = 2 * gw; row0 < 2 * 16384; row0 += 2 * NGW) {
        f32x4 v[2][4]; float am[2];
#pragma unroll
        for (int k = 0; k < 2; ++k) { const int row = row0 + k, tb = row >> 14, r = row & 16383;
            const f32x4* sp = (const f32x4*)((tb == 0 ? expert_u : expert_v) + (size_t)r * D + 16 * F.lane);
#pragma unroll
            for (int q = 0; q < 4; ++q) v[k][q] = sp[q]; }
#pragma unroll
        for (int k = 0; k < 2; ++k) { float a = 0.f;
#pragma unroll
            for (int q = 0; q < 4; ++q) a = fmaxf(a, fmaxf(fmaxf(fabsf(v[k][q].x), fabsf(v[k][q].y)), fmaxf(fabsf(v[k][q].z), fabsf(v[k][q].w))));
            am[k] = a; }
#pragma unroll
        for (int o = 1; o < 64; o <<= 1) { am[0] = fmaxf(am[0], __shfl_xor(am[0], o)); am[1] = fmaxf(am[1], __shfl_xor(am[1], o)); }
#pragma unroll
        for (int k = 0; k < 2; ++k) { const int row = row0 + k, tb = row >> 14, r = row & 16383;
            const float scale = am[k] > 0.f ? am[k] * (1.f / 7.5f) : 1.f, inv = 1.f / scale;
            unsigned c[16];
#pragma unroll
            for (int q = 0; q < 4; ++q) {
#pragma unroll
                for (int i = 0; i < 4; ++i) {
                    const float x = v[k][q][i] * inv, a = fminf(fabsf(x), 7.5f);
                    int e = (int)(__builtin_bit_cast(unsigned, a) >> 23) - 127; e = e < 0 ? 0 : e;
                    const float m8 = __builtin_rintf(a * __builtin_bit_cast(float, (unsigned)(130 - e) << 23));
                    c[4 * q + i] = ((unsigned)(int)m8 + 8u * (unsigned)e) | (x < 0.f ? 32u : 0u); }
            }
            unsigned long long lo = 0ull;
#pragma unroll
            for (int i = 0; i < 10; ++i) lo |= (unsigned long long)c[i] << (6 * i);
            lo |= (unsigned long long)c[10] << 60;
            const unsigned d2 = (c[10] >> 4) | (c[11] << 2) | (c[12] << 8) | (c[13] << 14) | (c[14] << 20) | (c[15] << 26);
            *(v3u_a4*)(F.ws + (tb == 0 ? ws_eux(F.lane >> 3) + (size_t)r * 128 + 12 * (F.lane & 7)
                                      : WS_EV6 + (size_t)r * 768 + 12 * F.lane)) = (v3u){(unsigned)lo, (unsigned)(lo >> 32), d2};
            if (F.lane == 0) ((float*)(F.ws + WS_ESC))[row] = scale; }
    }
}

__device__ __forceinline__ void p10_h2(Frame& F) {
    const float* norm2_w = late_arg(17);
    const int gw = blockIdx.x * NWAVES + F.wave, NGW = F.G * NWAVES;
    const float* MOD = (const float*)(F.ws + WS_MOD); const bf16* X1 = (const bf16*)(F.ws + WS_R1); bf16* H2 = (bf16*)(F.ws + WS_H);
    {
        const float* sub_keys = late_arg(19); const bf16* WTQ = (const bf16*)(F.ws + WS_WTQ); bf16* WTF = (bf16*)(F.ws + WS_WTF);
        for (int row = gw; row < 2048; row += NGW) {
            const bf16* wq = WTQ + (size_t)(row >> 7) * 128 * D + 16 * F.lane; const float* sk = sub_keys + (size_t)row * 128;
            float a[16];
#pragma unroll
            for (int j = 0; j < 16; ++j) a[j] = 0.f;
#pragma unroll 4
            for (int d = 0; d < 128; ++d) { const float sv = sk[d]; const v4u w0 = *(const v4u*)(wq + (size_t)d * D), w1 = *(const v4u*)(wq + (size_t)d * D + 8);
#pragma unroll
                for (int e = 0; e < 4; ++e) { a[2 * e] = fmaf(sv, bflo(w0[e]), a[2 * e]); a[2 * e + 1] = fmaf(sv, bfhi(w0[e]), a[2 * e + 1]); a[8 + 2 * e] = fmaf(sv, bflo(w1[e]), a[8 + 2 * e]); a[9 + 2 * e] = fmaf(sv, bfhi(w1[e]), a[9 + 2 * e]); } }
            *(v4u*)(WTF + (size_t)row * D + 16 * F.lane) = (v4u){pk2(a[0], a[1]), pk2(a[2], a[3]), pk2(a[4], a[5]), pk2(a[6], a[7])};
            *(v4u*)(WTF + (size_t)row * D + 16 * F.lane + 8) = (v4u){pk2(a[8], a[9]), pk2(a[10], a[11]), pk2(a[12], a[13]), pk2(a[14], a[15])};
        }
    }
    for (int r0 = 2 * gw; r0 < NLAT; r0 += 2 * NGW) {
        v4u raw[2][2]; float ss[2];
#pragma unroll
        for (int k = 0; k < 2; ++k)
#pragma unroll
            for (int j = 0; j < 2; ++j) raw[k][j] = *(const v4u*)(X1 + (size_t)(r0 + k) * D + 512 * j + 8 * F.lane);
#pragma unroll
        for (int k = 0; k < 2; ++k) { float sq = 0.f;
#pragma unroll
            for (int j = 0; j < 2; ++j)
#pragma unroll
                for (int e = 0; e < 4; ++e) { const float a = bflo(raw[k][j][e]), b = bfhi(raw[k][j][e]); sq += a * a + b * b; }
            ss[k] = sq; }
#pragma unroll
        for (int o = 1; o < 64; o <<= 1) { ss[0] += __shfl_xor(ss[0], o); ss[1] += __shfl_xor(ss[1], o); }
        const float* md = MOD + (size_t)(r0 >> 13) * 6144;
#pragma unroll
        for (int j = 0; j < 2; ++j) { const int c0 = 512 * j + 8 * F.lane;
            const f32x4 w0 = *(const f32x4*)(norm2_w + c0), w1 = *(const f32x4*)(norm2_w + c0 + 4), h0 = *(const f32x4*)(md + 3072 + c0), h1 = *(const f32x4*)(md + 3072 + c0 + 4),
                        s0 = *(const f32x4*)(md + 4096 + c0), s1 = *(const f32x4*)(md + 4096 + c0 + 4);
#pragma unroll
            for (int k = 0; k < 2; ++k) { const float r = rsqrtf(ss[k] * (1.f / D) + EPS);
                const f32x4 x0 = (f32x4){bflo(raw[k][j].x), bfhi(raw[k][j].x), bflo(raw[k][j].y), bfhi(raw[k][j].y)}, x1 = (f32x4){bflo(raw[k][j].z), bfhi(raw[k][j].z), bflo(raw[k][j].w), bfhi(raw[k][j].w)};
                const f32x4 y0 = x0 * r * w0 * (s0 + 1.f) + h0, y1 = x1 * r * w1 * (s1 + 1.f) + h1;
                *(v4u*)(H2 + (size_t)(r0 + k) * D + c0) = (v4u){pk2(y0.x, y0.y), pk2(y0.z, y0.w), pk2(y1.x, y1.y), pk2(y1.z, y1.w)}; } }
    }
}

__device__ __forceinline__ void ins16(unsigned (&top)[16], unsigned x) {
#pragma unroll
    for (int k = 0; k < 16; ++k) { const unsigned hi = top[k] > x ? top[k] : x; x = top[k] > x ? x : top[k]; top[k] = hi; }
}
#define CAS_DESC(a, b) do { const unsigned hi_ = (a) > (b) ? (a) : (b), lo_ = (a) > (b) ? (b) : (a); (a) = hi_; (b) = lo_; } while (0)
__device__ __forceinline__ void bitonic_sort16_desc(unsigned (&v)[16]) {
#pragma unroll
    for (int k = 2; k <= 16; k <<= 1)
#pragma unroll
        for (int j = k >> 1; j > 0; j >>= 1)
#pragma unroll
            for (int i = 0; i < 16; ++i) { const int l = i ^ j; if (l > i) { if ((i & k) == 0) CAS_DESC(v[i], v[l]); else CAS_DESC(v[l], v[i]); } }
}
__device__ __forceinline__ void bitonic_merge16_desc(unsigned (&v)[16]) {
#pragma unroll
    for (int j = 8; j > 0; j >>= 1)
#pragma unroll
        for (int i = 0; i < 16; ++i) { const int l = i ^ j; if (l > i) CAS_DESC(v[i], v[l]); }
}
__device__ __forceinline__ float ord16_to_float(unsigned o) {
    const unsigned hb = (o & 0x8000u) ? (o ^ 0x8000u) : (~o & 0xffffu);
    return (float)__builtin_bit_cast(_Float16, (unsigned short)hb);
}
__device__ __forceinline__ void p12_topk(Frame& F) {
    const unsigned short* SCG = (const unsigned short*)(F.ws + WS_R1 + 128 * MiB);
    int* EIDX = (int*)(F.ws + WS_OB + 64 * MiB); float* EG = (float*)(F.ws + WS_OB + 80 * MiB);
    const int lane = F.lane, h = F.wave, tok = 16 * (lane & 3) + (lane >> 2);
    LAS unsigned char* PAY = (LAS unsigned char*)(F.lds + h * 16384);
    for (int item = blockIdx.x; item < NLAT / 64; item += F.G) {
        const int t0 = item * 64;
        unsigned top[2][16];
#pragma unroll
        for (int c = 0; c < 2; ++c) {
#pragma unroll
            for (int k = 0; k < 16; ++k) top[c][k] = 0u;
            const unsigned short* sp = SCG + ((size_t)(item * 8 + h) * 2 + c) * 8192 + lane;
            unsigned short raw[16], nxt[16];
#pragma unroll
            for (int k = 0; k < 16; ++k) raw[k] = sp[k * 64];
#pragma unroll 1
            for (int g = 0; g < 8; ++g) {
                const int gn = g < 7 ? g + 1 : 7;
#pragma unroll
                for (int k = 0; k < 16; ++k) nxt[k] = sp[(gn * 16 + k) * 64];
                unsigned grp[16];
#pragma unroll
                for (int k = 0; k < 16; ++k) { const int key = g * 16 + k; const unsigned hb = raw[k];
                    const unsigned o = (hb & 0x8000u) ? (~hb & 0xffffu) : (hb | 0x8000u); grp[k] = (o << 16) | (unsigned)(127 - key); }
                bitonic_sort16_desc(grp);
#pragma unroll
                for (int k = 0; k < 16; ++k) top[c][k] = top[c][k] > grp[15 - k] ? top[c][k] : grp[15 - k];
                bitonic_merge16_desc(top[c]);
#pragma unroll
                for (int k = 0; k < 16; ++k) raw[k] = nxt[k];
            }
        }
        float f1[16], f2[16];
#pragma unroll
        for (int k = 0; k < 16; ++k) { f1[k] = ord16_to_float(top[0][k] >> 16); f2[k] = ord16_to_float(top[1][k] >> 16);
            PAY[k * 64 + lane] = (unsigned char)(127u - (top[0][k] & 127u)); PAY[(16 + k) * 64 + lane] = (unsigned char)(127u - (top[1][k] & 127u)); }
        unsigned best[16];
#pragma unroll
        for (int k = 0; k < 16; ++k) best[k] = 0u;
#pragma unroll
        for (int i = 0; i < 16; ++i)
#pragma unroll
            for (int j = 0; j < 16; ++j)
                if ((i + 1) * (j + 1) <= 16) {
                    const unsigned bits = __builtin_bit_cast(unsigned, f1[i] + f2[j]);
                    const unsigned u = bits ^ ((bits & 0x80000000u) ? 0xffffffffu : 0x80000000u);
                    ins16(best, (u & 0xffffff00u) | (unsigned)(255 - (i * 16 + j)));
                }
        float val[16], esum = 0.f;
#pragma unroll
        for (int k = 0; k < 16; ++k) { const unsigned u = best[k] & 0xffffff00u; val[k] = __builtin_bit_cast(float, (u & 0x80000000u) ? (u ^ 0x80000000u) : ~u); }
        const float vmax = val[0];
#pragma unroll
        for (int k = 0; k < 16; ++k) { val[k] = __expf(val[k] - vmax); esum += val[k]; }
        const float rs = 1.f / esum;
        asm volatile("s_waitcnt lgkmcnt(0)" ::: "memory");
        int eidx[16];
#pragma unroll
        for (int k = 0; k < 16; ++k) { const unsigned flat = 255u - (best[k] & 255u); const unsigned i = flat >> 4, j = flat & 15u;
            eidx[k] = (int)PAY[i * 64 + lane] * 128 + (int)PAY[(16 + j) * 64 + lane]; }
        const size_t ob = ((size_t)(t0 + tok) * 8 + h) * 16;
        const float* ESC = (const float*)(F.ws + WS_ESC);
        float* EUS = (float*)(F.ws + WS_OB + 96 * MiB);
#pragma unroll
        for (int q = 0; q < 4; ++q) {
            *(v4u*)(EIDX + ob + 4 * q) = (v4u){(unsigned)eidx[4 * q], (unsigned)eidx[4 * q + 1], (unsigned)eidx[4 * q + 2], (unsigned)eidx[4 * q + 3]};
            *(f32x4*)(EG + ob + 4 * q) = (f32x4){val[4 * q] * rs * ESC[16384 + eidx[4 * q]], val[4 * q + 1] * rs * ESC[16384 + eidx[4 * q + 1]], val[4 * q + 2] * rs * ESC[16384 + eidx[4 * q + 2]], val[4 * q + 3] * rs * ESC[16384 + eidx[4 * q + 3]]};
            *(f32x4*)(EUS + ob + 4 * q) = (f32x4){ESC[eidx[4 * q]], ESC[eidx[4 * q + 1]], ESC[eidx[4 * q + 2]], ESC[eidx[4 * q + 3]]};
        }
    }
}

typedef __bf16 bf2_t __attribute__((ext_vector_type(2)));
__device__ __forceinline__ float dot2bf(unsigned a, unsigned b, float c) { return __builtin_amdgcn_fdot2_f32_bf16(__builtin_bit_cast(bf2_t, a), __builtin_bit_cast(bf2_t, b), c, false); }
template <int CTRL, int RMASK> __device__ __forceinline__ float dpp_get(float x) { return __builtin_bit_cast(float, __builtin_amdgcn_update_dpp(0, __builtin_bit_cast(int, x), CTRL, RMASK, 0xF, false)); }
__device__ __forceinline__ float wave_sum_uniform(float s) {
    s += dpp_get<0xB1, 0xF>(s); s += dpp_get<0x4E, 0xF>(s); s += dpp_get<0x124, 0xF>(s); s += dpp_get<0x128, 0xF>(s);
    s += dpp_get<0x142, 0xA>(s); s += dpp_get<0x143, 0xC>(s);
    return __builtin_bit_cast(float, __builtin_amdgcn_readlane(__builtin_bit_cast(int, s), 63));
}
__device__ __forceinline__ float gelu_erf(float v) {
    const float av = fabsf(v), t = __builtin_amdgcn_rcpf(fmaf(av, 0.2316418882f, 1.0f));
    float q = fmaf(t, 0.5307027145f, -0.7265760135f); q = fmaf(q, t, 0.7107068705f); q = fmaf(q, t, -0.142248368f); q = fmaf(q, t, 0.127414796f); q = q * t;
    const float e = __builtin_amdgcn_exp2f(v * v * -0.72134752044f);
    const float m = v * (q * e);
    return v < 0.f ? m : v - m;
}
__device__ __forceinline__ float half_sum_sel(float s, int hf) {
    s += dpp_get<0xB1, 0xF>(s); s += dpp_get<0x4E, 0xF>(s); s += dpp_get<0x124, 0xF>(s); s += dpp_get<0x128, 0xF>(s);
    s += dpp_get<0x142, 0xA>(s);
    const int lo = __builtin_amdgcn_readlane(__builtin_bit_cast(int, s), 31), hi = __builtin_amdgcn_readlane(__builtin_bit_cast(int, s), 63);
    return __builtin_bit_cast(float, hf ? hi : lo);
}
__device__ __forceinline__ v6u ld6(const unsigned char* p) { const v4u a = *(const v4u_a8*)p; const v2u b = *(const v2u*)(p + 16); return (v6u){a.x, a.y, a.z, a.w, b.x, b.y}; }
__device__ __forceinline__ void p13a_peer_u(Frame& F) {
    const int lane = F.lane, tg = lane >> 2, un = lane & 3;
    const bf16* H2 = (const bf16*)(F.ws + WS_H);
    const int* EIDX = (const int*)(F.ws + WS_OB + 64 * MiB);
    float* PD = (float*)(F.ws + WS_R1 + 128 * MiB);
    const int classes = F.G < 8 ? F.G : 8, cls = (int)blockIdx.x % classes, nwg = (F.G - cls + classes - 1) / classes;
    const int ws = ((int)blockIdx.x / classes) * NWAVES + F.wave, nws = nwg * NWAVES;
    for (int x = cls; x < 8; x += classes) {
        const unsigned char* UX = F.ws + ws_eux(x) + 24 * un;
        for (int grp = ws; grp < NLAT / 16; grp += nws) {
            const int t = grp * 16 + tg;
            unsigned hp[16];
#pragma unroll
            for (int q = 0; q < 4; ++q) { const v4u a = *(const v4u*)(H2 + (size_t)t * D + 128 * x + 32 * un + 8 * q); hp[4 * q] = a.x; hp[4 * q + 1] = a.y; hp[4 * q + 2] = a.z; hp[4 * q + 3] = a.w; }
            const v4u* ep = (const v4u*)(EIDX + (size_t)t * NPEER);
            float* pd = PD + ((size_t)x * NLAT + t) * NPEER;
            v6u U0[4], U1[4], U2[4], U3[4];
#define PU_LOAD(U, e_) do { _Pragma("unroll") for (int j_ = 0; j_ < 4; ++j_) U[j_] = ld6(UX + (size_t)(e_)[j_] * 128); } while (0)
#define PU_COMP(U, s4) do { f32x4 dq_; _Pragma("unroll") for (int j_ = 0; j_ < 4; ++j_) { const v32bf ub_ = __builtin_amdgcn_cvt_scalef32_pk32_bf16_fp6(U[j_], 1.0f); float d_ = 0.f; \
                _Pragma("unroll") for (int i_ = 0; i_ < 16; ++i_) { const bf2_t a_ = {ub_[2 * i_], ub_[2 * i_ + 1]}; d_ = __builtin_amdgcn_fdot2_f32_bf16(a_, __builtin_bit_cast(bf2_t, hp[i_]), d_, false); } \
                d_ += dpp_get<0xB1, 0xF>(d_); d_ += dpp_get<0x4E, 0xF>(d_); dq_[j_] = d_; } \
            if (un == 0) *(f32x4*)(pd + 4 * (s4)) = dq_; } while (0)
            v4u e3 = ep[3];
            { const v4u e0 = ep[0], e1 = ep[1], e2 = ep[2]; PU_LOAD(U0, e0); PU_LOAD(U1, e1); PU_LOAD(U2, e2); }
            for (int s4 = 0; s4 < 32; s4 += 4) {
                const int nb = s4 + 4 < 32 ? s4 + 4 : 28;
                const v4u n0 = ep[nb], n1 = ep[nb + 1], n2 = ep[nb + 2], n3 = ep[nb + 3];
                PU_LOAD(U3, e3); PU_COMP(U0, s4);
                PU_LOAD(U0, n0); PU_COMP(U1, s4 + 1);
                PU_LOAD(U1, n1); PU_COMP(U2, s4 + 2);
                PU_LOAD(U2, n2); PU_COMP(U3, s4 + 3);
                e3 = n3;
            }
#undef PU_LOAD
#undef PU_COMP
        }
    }
}
__device__ __forceinline__ void p13_peer(Frame& F) {
    const float* final_norm_w = late_arg(22);
    const int gw = blockIdx.x * NWAVES + F.wave, NGW = F.G * NWAVES, lane = F.lane, hf = lane >> 5, li = lane & 31;
    const float* MOD = (const float*)(F.ws + WS_MOD); const bf16* X1 = (const bf16*)(F.ws + WS_R1);
    const unsigned char* EV6 = F.ws + WS_EV6;
    const int* EIDX = (const int*)(F.ws + WS_OB + 64 * MiB); const float* EG = (const float*)(F.ws + WS_OB + 80 * MiB); const float* EUS = (const float*)(F.ws + WS_OB + 96 * MiB);
    const float* PD = (const float*)(F.ws + WS_R1 + 128 * MiB);
    int eN0 = 0, eN1 = 0; float pN0[8], pN1[8], uN0 = 0.f, uN1 = 0.f, gN0 = 0.f, gN1 = 0.f;
#define PEER_TOK(tt) do { eN0 = EIDX[(size_t)(tt) * NPEER + lane]; eN1 = EIDX[(size_t)(tt) * NPEER + 64 + lane]; \
        uN0 = EUS[(size_t)(tt) * NPEER + lane]; uN1 = EUS[(size_t)(tt) * NPEER + 64 + lane]; gN0 = EG[(size_t)(tt) * NPEER + lane]; gN1 = EG[(size_t)(tt) * NPEER + 64 + lane]; \
        _Pragma("unroll") for (int x_ = 0; x_ < 8; ++x_) { pN0[x_] = PD[((size_t)x_ * NLAT + (tt)) * NPEER + lane]; pN1[x_] = PD[((size_t)x_ * NLAT + (tt)) * NPEER + 64 + lane]; } } while (0)
    if (gw < NLAT) PEER_TOK(gw);
    for (int t = gw; t < NLAT; t += NGW) {
        float y[32];
#pragma unroll
        for (int i = 0; i < 32; ++i) y[i] = 0.f;
        const int ei0 = eN0, ei1 = eN1;
        float d0 = 0.f, d1 = 0.f;
#pragma unroll
        for (int x_ = 0; x_ < 8; ++x_) { d0 += pN0[x_]; d1 += pN1[x_]; }
        const int ac0 = __builtin_bit_cast(int, gelu_erf(d0 * uN0) * gN0), ac1 = __builtin_bit_cast(int, gelu_erf(d1 * uN1) * gN1);
        { const int tn = t + NGW < NLAT ? t + NGW : t; PEER_TOK(tn); }
        constexpr int NPB = 4;
        v6u V0[NPB], V1[NPB]; int A0[NPB], A1[NPB];
#define PEER_LOAD(V, A, bt) do { const bool lo_ = (bt) < 32 / NPB; const int se_ = lo_ ? ei0 : ei1, sa_ = lo_ ? ac0 : ac1; \
            _Pragma("unroll") for (int p_ = 0; p_ < NPB; ++p_) { const int sl_ = ((((bt) * 2 * NPB + 2 * p_) & 63) + hf) << 2; \
                const unsigned off_ = (unsigned)__builtin_amdgcn_ds_bpermute(sl_, se_) * 768u + 24u * (unsigned)li; \
                V[p_] = ld6(EV6 + off_); A[p_] = __builtin_amdgcn_ds_bpermute(sl_, sa_); } } while (0)
#define PEER_COMP(V, A) do { \
            _Pragma("unroll") for (int p_ = 0; p_ < NPB; ++p_) { const float act_ = __builtin_bit_cast(float, A[p_]); \
                const v32f vv_ = __builtin_amdgcn_cvt_scalef32_pk32_f32_fp6(V[p_], 1.0f); \
                _Pragma("unroll") for (int j_ = 0; j_ < 32; ++j_) y[j_] = fmaf(act_, vv_[j_], y[j_]); } } while (0)
        PEER_LOAD(V0, A0, 0);
        for (int bt = 0; bt < 64 / NPB; bt += 2) {
            PEER_LOAD(V1, A1, bt + 1);
            PEER_COMP(V0, A0);
            PEER_LOAD(V0, A0, bt + 2 < 64 / NPB ? bt + 2 : 64 / NPB - 1);
            PEER_COMP(V1, A1);
        }
#undef PEER_LOAD
#undef PEER_COMP
        float yy[16];
#pragma unroll
        for (int i = 0; i < 16; ++i) { const float a = y[i] + __shfl_xor(y[i], 32), b = y[16 + i] + __shfl_xor(y[16 + i], 32); yy[i] = hf ? b : a; }
        const float* g2 = MOD + (size_t)(t >> 13) * 6144 + 5120;
        const int ch0 = 32 * li + 16 * hf;
        float x2[16]; float ss = 0.f;
        const v4u xa = *(const v4u*)(X1 + (size_t)t * D + ch0), xb = *(const v4u*)(X1 + (size_t)t * D + ch0 + 8);
#pragma unroll
        for (int q = 0; q < 4; ++q) { const int col = ch0 + 4 * q;
            const unsigned w0 = q < 2 ? xa[2 * q] : xb[2 * q - 4], w1 = q < 2 ? xa[2 * q + 1] : xb[2 * q - 3];
            const f32x4 xv = (f32x4){bflo(w0), bfhi(w0), bflo(w1), bfhi(w1)}, gv = *(const f32x4*)(g2 + col);
#pragma unroll
            for (int i = 0; i < 4; ++i) { const float v = xv[i] + gv[i] * yy[q * 4 + i]; x2[q * 4 + i] = v; ss += v * v; } }
        const float r = rsqrtf(wave_sum(ss) * (1.f / D) + EPS);
#pragma unroll
        for (int q = 0; q < 4; ++q) { const int col = ch0 + 4 * q; const f32x4 wv = *(const f32x4*)(final_norm_w + col); f32x4 o;
#pragma unroll
            for (int i = 0; i < 4; ++i) o[i] = x2[q * 4 + i] * r * wv[i];
            *(f32x4*)(F.out + (size_t)t * D + col) = o; }
    }
}
#undef PEER_TOK
struct Args { const float* in[23]; float* out; unsigned char* ws; };
__global__ void __launch_bounds__(NT, 2) fwd_megakernel(Args args) {
    extern __shared__ __attribute__((aligned(16))) unsigned char lds[];
    Frame F;
    F.lds = (LAS unsigned char*)lds;
    F.tid = threadIdx.x; F.lane = F.tid & 63; F.wave = __builtin_amdgcn_readfirstlane(F.tid >> 6); F.G = gridDim.x;
    F.x = args.in[0]; F.c = args.in[1]; F.ctx = args.in[2]; F.c_ctx = args.in[3]; F.w_ada = args.in[4]; F.b_ada = args.in[5]; F.norm1_w = args.in[6]; F.w_in = args.in[7];
    F.lb_logits = args.in[12]; F.w_pa = args.in[14];
    F.w_pb = args.in[15]; F.w_o = args.in[16]; F.w_query = args.in[18]; F.sub_keys = args.in[19];
    F.out = args.out; F.ws = args.ws;
    volatile LAS unsigned* MISC = (volatile LAS unsigned*)(F.lds + MISC_OFF);
    if (F.tid < 64) MISC[F.tid] = 0u;
    __syncthreads();
    XcdBarrier bar = xcd_barrier_post((unsigned*)(F.ws + WS_CTL) + CW_BAR, MISC + 8);
#define GRID_BAR() xcd_barrier(bar)
    unsigned char* ws = F.ws;
    bf16* OA = (bf16*)F.out;
    bf16* OB = (bf16*)(ws + WS_OB);

#ifndef PROBE_MASK
#define PROBE_MASK 0
#endif
#define PHASE_IDS() do { asm volatile("" : "+v"(F.tid)); F.lane = F.tid & 63; { GAS unsigned char* wg_ = (GAS unsigned char*)F.ws; GAS float* og_ = (GAS float*)F.out; asm volatile("" : "+s"(wg_), "+s"(og_)); F.ws = (unsigned char*)wg_; F.out = (float*)og_; } ws = F.ws; OA = (bf16*)F.out; OB = (bf16*)(ws + WS_OB); } while (0)
#define PH(k, ...) do { PHASE_IDS(); __VA_ARGS__; if ((PROBE_MASK >> (k)) & 1) { GRID_BAR(); __VA_ARGS__; } } while (0)
    PH(0, p0_prologue(F));
    GRID_BAR();
    PH(1, p1_h(F));
    GRID_BAR();
    PH(2, {
        pg8::Gemm g{(const pg8::bf16_t*)(ws + WS_H), (const pg8::bf16_t*)(ws + WS_WTA), NROW, NA, D}; pg8::StaticOrder S; S.init(NROW, NA, F.G, (int)blockIdx.x);
        pg8::EpiA E{(pg8::bf16_t*)(ws + WS_R1), (float*)(ws + WS_AB), late_arg(9), late_arg(10)};
        pg8::gemm_phase<pg8::EpiA, pg8::StaticOrder, true, true>(F.lds, g, S, E);
    });
    GRID_BAR();
    PH(3, p2b_gdn_prep(F));
    GRID_BAR();
    PH(15, p3a_gdn_tw(F));
    GRID_BAR();
    PH(4, p3_gdn_chunk(F, OA));
    GRID_BAR();
    PH(5, {
        pg8::Gemm g{(const pg8::bf16_t*)(ws + WS_H), (const pg8::bf16_t*)(ws + WS_WTB), NROW, 4096, D}; pg8::StaticOrder S; S.init(NROW, 4096, F.G, (int)blockIdx.x);
        pg8::EpiB E{(pg8::bf16_t*)(ws + WS_R1), (const float*)(ws + WS_LB)};
        pg8::gemm_phase<pg8::EpiB, pg8::StaticOrder, true, true>(F.lds, g, S, E);
    });
    GRID_BAR();
    PH(6, { p5_hg_chunk(F, OB); if (F.G < 256) side_work(F, (int)blockIdx.x, F.G); else if ((int)blockIdx.x < 128) side_work(F, (int)blockIdx.x, 128); });
    GRID_BAR();
    PHASE_IDS();
    {
        pg8::Gemm g{(const pg8::bf16_t*)(ws + WS_H) + (size_t)NCTX * D, (const pg8::bf16_t*)(ws + WS_WTC), NLAT, 4096, D}; pg8::StaticOrder S; S.init(NLAT, 4096, F.G, (int)blockIdx.x);
        pg8::EpiC E{(pg8::bf16_t*)(ws + WS_R1), (const pg8::bf16_t*)OA, (pg8::bf16_t*)(ws + WS_R1 + 128 * MiB), (pg8::bf16_t*)OB, late_arg(11), late_arg(13), (LAS float*)(F.lds + RING_BYTES)};
        pg8::gemm_phase<pg8::EpiC, pg8::StaticOrder, true, true>(F.lds, g, S, E);
    }
    GRID_BAR();
    PH(8, {
        pg8::Gemm g{(const pg8::bf16_t*)(ws + WS_R1 + 128 * MiB), (const pg8::bf16_t*)(ws + WS_WTPA), NLAT, 1024, D}; pg8::StaticOrder S; S.init(NLAT, 1024, F.G, (int)blockIdx.x);
        pg8::EpiGate E{(pg8::bf16_t*)(OA + (size_t)NLAT * 1024), (const pg8::bf16_t*)(ws + WS_R1), 0, nullptr};
        pg8::gemm_phase<pg8::EpiGate, pg8::StaticOrder, true, true>(F.lds, g, S, E);
    });
    GRID_BAR();
    PH(9, {
        pg8::Gemm g{(const pg8::bf16_t*)(ws + WS_R1 + 128 * MiB) + (size_t)NLAT * 1024, (const pg8::bf16_t*)(ws + WS_WTPA) + (size_t)1024 * D, NLAT, 1024, D}; pg8::StaticOrder S; S.init(NLAT, 1024, F.G, (int)blockIdx.x);
        pg8::EpiGate E{(pg8::bf16_t*)(OA + (size_t)NLAT * 1024), (const pg8::bf16_t*)(ws + WS_R1), 1024, (const pg8::bf16_t*)(OA + (size_t)NLAT * 1024)};
        pg8::gemm_phase<pg8::EpiGate, pg8::StaticOrder, true, true>(F.lds, g, S, E);
    });
    GRID_BAR();
    PH(10, {
        pg8::Gemm g{(const pg8::bf16_t*)(OA + (size_t)NLAT * 1024), (const pg8::bf16_t*)(ws + WS_WTO), NLAT, 1024, D}; pg8::StaticOrder S; S.init(NLAT, 1024, F.G, (int)blockIdx.x);
        pg8::EpiResid E{(pg8::bf16_t*)(ws + WS_R1), late_arg(0), (const float*)(ws + WS_MOD)};
        pg8::gemm_phase<pg8::EpiResid, pg8::StaticOrder, true, true>(F.lds, g, S, E);
    });
    GRID_BAR();
    PH(11, p10_h2(F));
    GRID_BAR();
    PH(12, {
        pg8::Gemm g{(const pg8::bf16_t*)(ws + WS_H), (const pg8::bf16_t*)(ws + WS_WTF), NLAT, 2048, D}; pg8::StaticOrder S; S.init(NLAT, 2048, F.G, (int)blockIdx.x);
        pg8::EpiScoreT E{(unsigned short*)(ws + WS_R1 + 128 * MiB)};
        pg8::gemm_phase<pg8::EpiScoreT, pg8::StaticOrder, true, true>(F.lds, g, S, E);
    });
    GRID_BAR();
    PH(13, p12_topk(F));
    GRID_BAR();
    PH(14, p13a_peer_u(F));
    GRID_BAR();
    PH(16, p13_peer(F));
}

extern "C" void kernel_launch(void* const* d_in, const int* in_sizes, int n_in, void* d_out, int out_size, void* d_ws, size_t ws_size, hipStream_t stream) {
    static int grid = 0;
    if (grid == 0) {
        if (n_in != 23 || ws_size < WS_END) { fprintf(stderr, "kernel_launch: unexpected n_in %d or ws_size %zu (< %zu)\n", n_in, ws_size, (size_t)WS_END); grid = -1; return; }
        int dev = 0, cus = 0, per_cu = 0;
        if (hipGetDevice(&dev) != hipSuccess || hipDeviceGetAttribute(&cus, hipDeviceAttributeMultiprocessorCount, dev) != hipSuccess) { grid = -1; return; }
        if (hipFuncSetAttribute((const void*)fwd_megakernel, hipFuncAttributeMaxDynamicSharedMemorySize, LDS_BYTES) != hipSuccess) { fprintf(stderr, "kernel_launch: hipFuncSetAttribute failed\n"); grid = -1; return; }
        if (hipOccupancyMaxActiveBlocksPerMultiprocessor(&per_cu, (const void*)fwd_megakernel, NT, LDS_BYTES) != hipSuccess || per_cu < 1) { fprintf(stderr, "kernel_launch: occupancy query says %d\n", per_cu); per_cu = 1; }
        (void)hipGetLastError();
        grid = cus;
    }
    if (grid < 0) return;
    (void)hipMemsetAsync((char*)d_ws + WS_CTL, 0, CTL_ZERO_BYTES, stream);
    Args a{};
    for (int i = 0; i < 23; ++i) a.in[i] = (const float*)d_in[i];
    a.out = (float*)d_out; a.ws = (unsigned char*)d_ws;
    hipLaunchKernelGGL(fwd_megakernel, dim3(grid), dim3(NT), LDS_BYTES, stream, a);
}
```

```cpp
#include <hip/hip_runtime.h>
#include <cstdio>
#include <cstdint>

#define GAS __attribute__((address_space(1)))
#define LAS __attribute__((address_space(3)))
typedef unsigned short bf16;
typedef unsigned v4u __attribute__((ext_vector_type(4)));
typedef unsigned v2u __attribute__((ext_vector_type(2)));
typedef float f32x4 __attribute__((ext_vector_type(4)));
typedef short bf16x8 __attribute__((ext_vector_type(8)));
typedef GAS unsigned gu32;
#define RLX_AGENT __ATOMIC_RELAXED, __HIP_MEMORY_SCOPE_AGENT
#define LDS_WAIT() asm volatile("s_waitcnt lgkmcnt(0)" ::: "memory")
#define VM_WAIT() asm volatile("s_waitcnt vmcnt(0)" ::: "memory")
typedef __bf16 hwbf2_t __attribute__((ext_vector_type(2)));
typedef float hwf2_t __attribute__((ext_vector_type(2)));
__device__ __forceinline__ unsigned f2bf(float f) { return (unsigned)__builtin_bit_cast(unsigned short, (__bf16)f); }
__device__ __forceinline__ unsigned pk2(float lo, float hi) { const hwf2_t v = {lo, hi}; return __builtin_bit_cast(unsigned, __builtin_convertvector(v, hwbf2_t)); }
__device__ __forceinline__ float bf2f(unsigned short b) { return __builtin_bit_cast(float, (unsigned)b << 16); }
__device__ __forceinline__ float bflo(unsigned w) { return __builtin_bit_cast(float, w << 16); }
__device__ __forceinline__ float bfhi(unsigned w) { return __builtin_bit_cast(float, w & 0xffff0000u); }
__device__ __forceinline__ float sigmoidf_(float x) { return __builtin_amdgcn_rcpf(1.f + __builtin_amdgcn_exp2f(x * -1.44269504089f)); }
__device__ __forceinline__ float siluf_(float x) { return x * __builtin_amdgcn_rcpf(1.f + __builtin_amdgcn_exp2f(x * -1.44269504089f)); }
__device__ __forceinline__ float softplusf_(float x) { return x > 20.f ? x : __builtin_amdgcn_logf(1.f + __builtin_amdgcn_exp2f(x * 1.44269504089f)) * 0.69314718056f; }
__device__ __forceinline__ float wave_sum(float v) {
#pragma unroll
    for (int o = 1; o < 64; o <<= 1) v += __shfl_xor(v, o);
    return v;
}
namespace pg8 {
#define PG8_LAS __attribute__((address_space(3)))
typedef unsigned short bf16_t;
typedef short bf16x8 __attribute__((ext_vector_type(8)));
typedef float f32x4 __attribute__((ext_vector_type(4)));
typedef unsigned u32x4 __attribute__((ext_vector_type(4)));
constexpr int BM = 256, BK = 64, HALF = 128, HTB = HALF * BK * 2  , STAGE_BYTES = 8 * HTB, NXCD = 8, WGM = 8;

__host__ __device__ __forceinline__ int lds_byte(int r, int c) { const int st = (r >> 4) * 2 + (c >> 5), rr = r & 15, cc = c & 31, ob = rr * 64 + cc * 2; return st * 1024 + (ob ^ (((ob >> 9) & 1) << 5)); }
__host__ __device__ __forceinline__ void stage_rc(int b, int& R, int& C) { const int st = b / 1024, sb = b % 1024, swz = sb ^ (((sb >> 9) & 1) << 5); R = (st >> 1) * 16 + swz / 64; C = (st & 1) * 32 + (swz % 64) / 2; }
__host__ __device__ __forceinline__ int perm32(int rho) { const int n = rho >> 4, i = rho & 15; return 8 * (i >> 2) + 4 * n + (i & 3); }

struct Unit { int pm, pn; };
struct Gemm { const bf16_t* A; const bf16_t* Bt; int M, N, K; };

struct StaticOrder {
    int nM, nN, nwg, G, c;
    __host__ __device__ void init(int M, int N, int G_, int c_) { nM = M / BM; nN = N / BM; nwg = nM * nN; G = G_; c = c_; }
    __host__ __device__ bool next(int i, Unit& u) const {
        const long L = (long)i * G + c; if (L >= nwg) return false;
        int wgid = (int)L; { const int q = nwg / NXCD, r = nwg % NXCD, xcd = wgid % NXCD, off = wgid / NXCD; wgid = (xcd < r ? xcd * (q + 1) : r * (q + 1) + (xcd - r) * q) + off; }
        const int nig = WGM * nN, gid = wgid / nig, fm = gid * WGM, gsz = (nM - fm) < WGM ? (nM - fm) : WGM;
        u.pm = fm + ((wgid % nig) % gsz); u.pn = (wgid % nig) / gsz; return true;
    }
    __device__ __forceinline__ void a_ready(const Unit&) const {}
    __device__ __forceinline__ void done(const Unit&) const {}
};

__device__ __forceinline__ unsigned cvt_pk_bf16(float lo, float hi) { unsigned r; asm volatile("v_cvt_pk_bf16_f32 %0, %1, %2" : "=v"(r) : "v"(lo), "v"(hi)); return r; }
typedef float f32x2 __attribute__((ext_vector_type(2)));
template <class Epi, class Sched, bool ALIGN_EPI = false, bool SP2 = false>
__device__ __forceinline__ void gemm_phase(PG8_LAS unsigned char* lds, const Gemm g, const Sched& S, const Epi& E) {
    int tid_ = threadIdx.x; asm volatile("" : "+v"(tid_));
    const int tid = tid_, wid = __builtin_amdgcn_readfirstlane(tid >> 6), lane = tid & 63, wr = wid >> 2, wc = wid & 3, fr = lane & 15, fq = lane >> 4;
    const int K = g.K, nt = K / BK;
    unsigned voffA[2], voffB[2];
#pragma unroll
    for (int i = 0; i < 2; ++i) { int R, C; stage_rc(tid * 16 + i * 8192, R, C); const int Rb = Epi::PERM ? ((R & ~31) + perm32(R & 31)) : R;
        voffA[i] = (unsigned)(R * K + C) * 2u; voffB[i] = (unsigned)(Rb * K + C) * 2u; }
    const size_t kstep = (size_t)(BK * 2);
    const size_t hstep = (size_t)HALF * K * 2;
    const size_t tstep = 2 * hstep;
    const unsigned ldsw = (unsigned)wid * 1024u;
    const int aoff = lds_byte(wr * 64 + fr, fq * 8), boff = lds_byte(wc * 32 + fr, fq * 8);
#define PG8_SA(b, h) (((b) * 2 + (h)) * HTB)
#define PG8_SB(b, h) ((4 + (b) * 2 + (h)) * HTB)
#define PG8_STAGE(bufoff, gbase, voff) do { _Pragma("unroll") for (int _i = 0; _i < 2; ++_i) \
        __builtin_amdgcn_global_load_lds((const unsigned*)((const char*)(gbase) + (voff)[_i]), (PG8_LAS unsigned*)(lds + (bufoff) + ldsw + _i * 8192), 16, 0, 0); } while (0)
#define PG8_LDA(dst, b, h) do { _Pragma("unroll") for (int m = 0; m < 4; ++m) _Pragma("unroll") for (int k = 0; k < 2; ++k) dst[m][k] = *(const PG8_LAS bf16x8*)(lds + PG8_SA(b, h) + aoff + m * 2048 + k * 1024); } while (0)
#define PG8_LDB(dst, b, h) do { _Pragma("unroll") for (int n = 0; n < 2; ++n) _Pragma("unroll") for (int k = 0; k < 2; ++k) dst[n][k] = *(const PG8_LAS bf16x8*)(lds + PG8_SB(b, h) + boff + n * 2048 + k * 1024); } while (0)
#define PG8_MMA(ai, bj, At, Bt) do { __builtin_amdgcn_s_setprio(1); _Pragma("unroll") for (int m = 0; m < 4; ++m) _Pragma("unroll") for (int n = 0; n < 2; ++n) _Pragma("unroll") for (int k = 0; k < 2; ++k) \
        acc[ai][bj][m][n] = __builtin_amdgcn_mfma_f32_16x16x32_bf16(Bt[n][k], At[m][k], acc[ai][bj][m][n], 0, 0, 0); __builtin_amdgcn_s_setprio(0); } while (0)
#define PG8_WAIT_V(n) asm volatile("s_waitcnt vmcnt(" #n ")" ::: "memory")
#define PG8_WAIT_L(n) asm volatile("s_waitcnt lgkmcnt(" #n ")" ::: "memory")
#define PG8_BAR __builtin_amdgcn_s_barrier()
#define PG8_SCHED __builtin_amdgcn_sched_barrier(0)
    Unit cur, nxt; int ui = 0;
    if (!S.next(0, cur)) return;
    f32x4 acc[2][2][4][2];
#pragma unroll
    for (int a = 0; a < 2; ++a)
#pragma unroll
        for (int b = 0; b < 2; ++b)
#pragma unroll
            for (int m = 0; m < 4; ++m)
#pragma unroll
                for (int n = 0; n < 2; ++n) acc[a][b][m][n] = (f32x4){0.f, 0.f, 0.f, 0.f};
    bf16x8 At[4][2], B0[2][2], B1[2][2];
    const char* cA = (const char*)g.A + (size_t)cur.pm * tstep; const char* cB = (const char*)g.Bt + (size_t)cur.pn * tstep;
    S.a_ready(cur);
    if constexpr (SP2) {
        PG8_STAGE(PG8_SB(0, 0), cB, voffB); PG8_STAGE(PG8_SB(0, 1), cB + hstep, voffB); PG8_STAGE(PG8_SA(0, 0), cA, voffA); PG8_STAGE(PG8_SA(0, 1), cA + hstep, voffA);
        if (wr == 1) PG8_BAR;
        PG8_WAIT_V(2); PG8_BAR;
        PG8_STAGE(PG8_SB(1, 0), cB + kstep, voffB); PG8_STAGE(PG8_SA(1, 0), cA + kstep, voffA); PG8_STAGE(PG8_SB(1, 1), cB + hstep + kstep, voffB);
        PG8_WAIT_V(6); PG8_BAR;
    } else {
        PG8_STAGE(PG8_SB(0, 0), cB, voffB); PG8_STAGE(PG8_SA(0, 0), cA, voffA); PG8_STAGE(PG8_SB(0, 1), cB + hstep, voffB); PG8_STAGE(PG8_SA(0, 1), cA + hstep, voffA);
        if (wr == 1) PG8_BAR;
        PG8_WAIT_V(4); PG8_BAR;
        PG8_STAGE(PG8_SB(1, 0), cB + kstep, voffB); PG8_STAGE(PG8_SA(1, 0), cA + kstep, voffA); PG8_STAGE(PG8_SB(1, 1), cB + hstep + kstep, voffB);
        PG8_WAIT_V(6); PG8_BAR;
    }
    for (;;) {
        const bool has_next = S.next(ui + 1, nxt);
        const char* nA = has_next ? (const char*)g.A + (size_t)nxt.pm * tstep : cA; const char* nB = has_next ? (const char*)g.Bt + (size_t)nxt.pn * tstep : cB;
        for (int t = 0; t < nt; t += 2) {
            const bool last = (t == nt - 2);
            if constexpr (Epi::MIDK) { if (t == nt / 2) E.midk(acc, cur, wr, wc, fr, fq); }
            const char* a1 = cA + (size_t)(t + 1) * kstep;
            const char* a2 = last ? nA : cA + (size_t)(t + 2) * kstep; const char* b2 = last ? nB : cB + (size_t)(t + 2) * kstep;
            const char* a3 = a2 + kstep; const char* b3 = b2 + kstep;
            if (last && has_next) S.a_ready(nxt);
            if constexpr (SP2) {
            PG8_LDB(B0, 0, 0); PG8_LDB(B1, 0, 1); PG8_SCHED; PG8_LDA(At, 0, 0); PG8_STAGE(PG8_SA(1, 1), a1 + hstep, voffA);
            PG8_WAIT_V(8); PG8_WAIT_L(0); PG8_BAR; PG8_MMA(0, 0, At, B0); PG8_MMA(0, 1, At, B1); PG8_BAR; PG8_SCHED;
            PG8_LDA(At, 0, 1); PG8_STAGE(PG8_SB(0, 0), b2, voffB); PG8_STAGE(PG8_SB(0, 1), b2 + hstep, voffB); PG8_STAGE(PG8_SA(0, 0), a2, voffA);
            PG8_WAIT_V(8); PG8_WAIT_L(0); PG8_BAR; PG8_MMA(1, 0, At, B0); PG8_MMA(1, 1, At, B1); PG8_BAR; PG8_SCHED;
            PG8_LDB(B0, 1, 0); PG8_LDB(B1, 1, 1); PG8_SCHED; PG8_LDA(At, 1, 0); PG8_STAGE(PG8_SA(0, 1), a2 + hstep, voffA);
            PG8_WAIT_V(8); PG8_WAIT_L(0); PG8_BAR; PG8_MMA(0, 0, At, B0); PG8_MMA(0, 1, At, B1); PG8_BAR; PG8_SCHED;
            PG8_LDA(At, 1, 1); PG8_STAGE(PG8_SB(1, 0), b3, voffB); PG8_STAGE(PG8_SB(1, 1), b3 + hstep, voffB); PG8_STAGE(PG8_SA(1, 0), a3, voffA);
            PG8_WAIT_V(8); PG8_WAIT_L(0); PG8_BAR; PG8_MMA(1, 0, At, B0); PG8_MMA(1, 1, At, B1); PG8_BAR; PG8_SCHED;
            } else {
            PG8_LDB(B0, 0, 0); PG8_SCHED; PG8_LDA(At, 0, 0); PG8_STAGE(PG8_SA(1, 1), a1 + hstep, voffA);
            PG8_WAIT_L(8); PG8_BAR; PG8_WAIT_L(0); PG8_MMA(0, 0, At, B0); PG8_BAR; PG8_SCHED;
            PG8_LDB(B1, 0, 1); PG8_STAGE(PG8_SB(0, 0), b2, voffB);
            PG8_BAR; PG8_WAIT_L(0); PG8_MMA(0, 1, At, B1); PG8_BAR;
            PG8_LDA(At, 0, 1); PG8_STAGE(PG8_SA(0, 0), a2, voffA);
            PG8_BAR; PG8_WAIT_L(0); PG8_MMA(1, 0, At, B0); PG8_BAR; PG8_SCHED;
            PG8_STAGE(PG8_SB(0, 1), b2 + hstep, voffB);
            PG8_WAIT_V(6); PG8_BAR; PG8_MMA(1, 1, At, B1); PG8_BAR;
            PG8_LDB(B0, 1, 0); PG8_SCHED; PG8_LDA(At, 1, 0); PG8_STAGE(PG8_SA(0, 1), a2 + hstep, voffA);
            PG8_WAIT_L(8); PG8_BAR; PG8_WAIT_L(0); PG8_MMA(0, 0, At, B0); PG8_BAR; PG8_SCHED;
            PG8_LDB(B1, 1, 1); PG8_STAGE(PG8_SB(1, 0), b3, voffB);
            PG8_BAR; PG8_WAIT_L(0); PG8_MMA(0, 1, At, B1); PG8_BAR;
            PG8_LDA(At, 1, 1); PG8_STAGE(PG8_SA(1, 0), a3, voffA);
            PG8_BAR; PG8_WAIT_L(0); PG8_MMA(1, 0, At, B0); PG8_BAR; PG8_SCHED;
            PG8_STAGE(PG8_SB(1, 1), b3 + hstep, voffB);
            PG8_WAIT_V(6); PG8_BAR; PG8_MMA(1, 1, At, B1); PG8_BAR;
            }
        }
        if constexpr (ALIGN_EPI) { if (wr == 0) PG8_BAR; }
        if constexpr (!Epi::AFTER_DRAIN) { E(acc, cur, wr, wc, fr, fq); S.done(cur); }
        if (!has_next) break;
#pragma unroll
        for (int a = 0; a < 2; ++a)
#pragma unroll
            for (int b = 0; b < 2; ++b)
#pragma unroll
                for (int m = 0; m < 4; ++m)
#pragma unroll
                    for (int n = 0; n < 2; ++n) acc[a][b][m][n] = (f32x4){0.f, 0.f, 0.f, 0.f};
        cur = nxt; cA = nA; cB = nB; ++ui;
        if constexpr (ALIGN_EPI) { if (wr == 1) PG8_BAR; }
    }
    PG8_WAIT_V(0);
    if constexpr (!ALIGN_EPI) { if (wr == 0) PG8_BAR; }
    PG8_BAR;
    if constexpr (Epi::AFTER_DRAIN) { E.fused(acc, cur, wr, wc, fr, fq, lds, wid, lane); S.done(cur); }
#undef PG8_SA
#undef PG8_SB
#undef PG8_STAGE
#undef PG8_LDA
#undef PG8_LDB
#undef PG8_MMA
#undef PG8_WAIT_V
#undef PG8_WAIT_L
#undef PG8_BAR
#undef PG8_SCHED
}
}
#define XB_TMO      128
#define XB_XCNT(j)  (256  + 64 * (j))
#define XB_XSUB(j)  (1280 + 64 * (j))
#define XB_XGEN(j)  (2304 + 64 * (j))
#define XB_TOP      3328
#define XB_TOPGEN   3392
#define XCD_BAR_WORDS 3456
#define XB_SPIN_CAP (1u << 22)

__device__ __forceinline__ unsigned xb_ld(unsigned* p)              { return __hip_atomic_load(p, __ATOMIC_RELAXED, __HIP_MEMORY_SCOPE_AGENT); }
__device__ __forceinline__ unsigned xb_add(unsigned* p, unsigned v) { return __hip_atomic_fetch_add(p, v, __ATOMIC_RELAXED, __HIP_MEMORY_SCOPE_AGENT); }
__device__ __forceinline__ unsigned xb_xcc_id() { return (unsigned)__builtin_amdgcn_s_getreg((3 << 11) | 20) & 0xFu; }
#define XB_SPIN(cond, bar) do { unsigned _sp = 0; while (cond) { __builtin_amdgcn_s_sleep(1); \
    if ((++_sp & 255u) == 0u) { if (xb_ld(&(bar)[XB_TMO])) break; if (_sp > XB_SPIN_CAP) { atomicAdd(&(bar)[XB_TMO], 1u); break; } } } } while (0)

struct XcdBarrier {
    unsigned* bar; unsigned x;
    volatile LAS unsigned* st;
};

__device__ __forceinline__ XcdBarrier xcd_barrier_post(unsigned* bar, volatile LAS unsigned* st) {
    XcdBarrier b; b.bar = bar; b.x = xb_xcc_id(); b.st = st;
    if (threadIdx.x == 0) (void)xb_add(&bar[XB_XCNT(b.x)], 1u);
    return b;
}
__device__ __forceinline__ void xcd_barrier_complete(unsigned* bar, unsigned x, unsigned& nloc, unsigned& nx) {
    const unsigned G = gridDim.x * gridDim.y * gridDim.z;
    unsigned sum, cnt, mine, sp = 0u;
    for (;;) {
        sum = 0u; cnt = 0u; mine = 0u;
#pragma unroll
        for (unsigned j = 0; j < 16; ++j) { const unsigned c = xb_ld(&bar[XB_XCNT(j)]); sum += c; cnt += (c > 0u) ? 1u : 0u; mine = (j == x) ? c : mine; }
        if (sum == G) break;
        __builtin_amdgcn_s_sleep(1);
        if ((++sp & 255u) == 0u) { if (xb_ld(&bar[XB_TMO])) break; if (sp > XB_SPIN_CAP) { atomicAdd(&bar[XB_TMO], 1u); break; } }
    }
    nloc = mine > 0u ? mine : 1u; nx = cnt > 0u ? cnt : 1u;
}

__device__ __forceinline__ void xcd_barrier(const XcdBarrier& b) {
    asm volatile("s_waitcnt vmcnt(0)" ::: "memory");
    __syncthreads();
    if (threadIdx.x == 0) {
        unsigned* bar = b.bar;
        __builtin_amdgcn_s_waitcnt(0);
        unsigned nloc = b.st[0], nx = b.st[1];
        if (nloc == 0u) { xcd_barrier_complete(bar, b.x, nloc, nx); b.st[0] = nloc; b.st[1] = nx; }
        const unsigned old = xb_add(&bar[XB_XSUB(b.x)], 1u);
        const unsigned gen = old / nloc;
        if (old + 1u == (gen + 1u) * nloc) {
            __builtin_amdgcn_fence(__ATOMIC_RELEASE, "agent");
            asm volatile("s_waitcnt vmcnt(0)" ::: "memory");
            const unsigned og = xb_add(&bar[XB_TOP], 1u);
            const unsigned tg = og / nx;
            if (og + 1u == (tg + 1u) * nx) xb_add(&bar[XB_TOPGEN], 1u);
            else XB_SPIN(xb_ld(&bar[XB_TOPGEN]) == tg, bar);
            __builtin_amdgcn_fence(__ATOMIC_ACQUIRE, "agent");
            xb_add(&bar[XB_XGEN(b.x)], 1u);
            asm volatile("s_waitcnt vmcnt(0)" ::: "memory");
        } else {
            XB_SPIN(xb_ld(&bar[XB_XGEN(b.x)]) == gen, bar);
            __builtin_amdgcn_fence(__ATOMIC_ACQUIRE, "agent");
            asm volatile("s_waitcnt vmcnt(0)" ::: "memory");
        }
    }
    __syncthreads();
}
constexpr int NWAVES = 8, NT = 512;
constexpr int D = 1024, NB = 4, SEQ = 8192, CTX = 256;
constexpr int NCTX = NB * CTX;
constexpr int NLAT = NB * SEQ;
constexpr int NROW = NCTX + NLAT;
constexpr int NIN = 11296;
constexpr float EPS = 1e-6f;
constexpr float QSCALE = 0.08838834764831845f;
constexpr int C_QKV = 0, C_GA = 3072, C_AB = 4096, C_QB = 4128, C_GB = 8224, C_MG = 9248;
constexpr int NA = 3328;
constexpr int NPEER = 128;

constexpr size_t MiB = 1u << 20;
constexpr size_t WS_CTL = 0, CTL_ZERO_BYTES = 65536;
constexpr size_t WS_MOD = 65536, WS_LB = 196608, WS_SKB = 262144;
constexpr size_t WS_WTA = 1 * MiB, WS_WTB = 8 * MiB, WS_WTC = 16 * MiB, WS_WTPA = 24 * MiB, WS_WTPB = 26 * MiB, WS_WTO = 28 * MiB, WS_WTQ = 30 * MiB;
constexpr size_t WS_H = 34 * MiB;
constexpr size_t WS_AB = 100 * MiB;
constexpr size_t WS_R1 = 105 * MiB;
constexpr size_t WS_OB = 369 * MiB;
constexpr size_t WS_QKVC = 303 * MiB;
constexpr size_t WS_WTF = 16 * MiB;
__host__ __device__ constexpr size_t ws_eux(int x) { return x < 7 ? (size_t)(1 + 2 * x) * MiB : (size_t)509 * MiB; }
constexpr size_t WS_EV6 = 497 * MiB;
constexpr size_t WS_ESC = 15 * MiB;
constexpr size_t WS_GCB = 501 * MiB;
constexpr size_t WS_END = 511 * MiB;
constexpr int CW_BAR = 1024;

constexpr int RING_BYTES = 131072;
constexpr int LDS_BYTES = 147456;
constexpr int MISC_OFF = LDS_BYTES - 256;

__device__ __forceinline__ const float* late_arg(int i) {
    const __attribute__((address_space(4))) char* kp = (const __attribute__((address_space(4))) char*)__builtin_amdgcn_kernarg_segment_ptr();
    asm volatile("" : "+s"(kp));
    return (const float*)*(const GAS float* const __attribute__((address_space(4)))*)(kp + 8 * i);
}
struct Frame {
    LAS unsigned char* lds;
    int tid, lane, wave, G;
    const float *x, *c, *ctx, *c_ctx, *w_ada, *b_ada, *norm1_w, *w_in, *conv_w, *a_log, *dt_bias, *gdn_norm_w, *lb_logits, *hg_norm_w, *w_pa, *w_pb, *w_o, *norm2_w, *w_query,
        *sub_keys, *expert_u, *expert_v, *final_norm_w;
    float* out; unsigned char* ws;
};

namespace pg8 {
struct EpiStore {
    static constexpr bool PERM = true, AFTER_DRAIN = false, MIDK = false;
    bf16_t* O; int ldc;
    __device__ __forceinline__ void operator()(const f32x4 (&acc)[2][2][4][2], const Unit& u, int wr, int wc, int fr, int fq) const {
        asm volatile("" : "+v"(fr), "+v"(fq));
        const int row0 = u.pm * BM + wr * 64 + fr, col0 = u.pn * BM + wc * 32 + 8 * fq;
#pragma unroll
        for (int ai = 0; ai < 2; ++ai)
#pragma unroll
            for (int m = 0; m < 4; ++m) { bf16_t* rowp = O + (size_t)(row0 + ai * HALF + m * 16) * ldc + col0;
#pragma unroll
                for (int bj = 0; bj < 2; ++bj) { const f32x4 v0 = acc[ai][bj][m][0], v1 = acc[ai][bj][m][1];
                    u32x4 w; w.x = cvt_pk_bf16(v0[0], v0[1]); w.y = cvt_pk_bf16(v0[2], v0[3]); w.z = cvt_pk_bf16(v1[0], v1[1]); w.w = cvt_pk_bf16(v1[2], v1[3]);
                    *(u32x4*)(rowp + bj * HALF) = w; } }
    }
};
struct EpiScoreT {
    static constexpr bool PERM = true, AFTER_DRAIN = false, MIDK = false;
    unsigned short* O;
    __device__ __forceinline__ void operator()(const f32x4 (&acc)[2][2][4][2], const Unit& u, int wr, int wc, int fr, int fq) const {
        asm volatile("" : "+v"(fr), "+v"(fq));
#pragma unroll
        for (int ai = 0; ai < 2; ++ai) {
            const int tb = u.pm * 4 + ai * 2 + wr;
#pragma unroll
            for (int bj = 0; bj < 2; ++bj) {
                unsigned short* bp = O + ((size_t)(tb * 8 + u.pn) * 2 + bj) * 8192 + (wc * 32 + 8 * fq) * 64 + 4 * fr;
#pragma unroll
                for (int n = 0; n < 2; ++n)
#pragma unroll
                    for (int i = 0; i < 4; ++i) {
                        const unsigned lo = (unsigned)__builtin_bit_cast(unsigned short, (_Float16)acc[ai][bj][0][n][i]) | ((unsigned)__builtin_bit_cast(unsigned short, (_Float16)acc[ai][bj][1][n][i]) << 16);
                        const unsigned hi = (unsigned)__builtin_bit_cast(unsigned short, (_Float16)acc[ai][bj][2][n][i]) | ((unsigned)__builtin_bit_cast(unsigned short, (_Float16)acc[ai][bj][3][n][i]) << 16);
                        *(v2u*)(bp + (4 * n + i) * 64) = (v2u){lo, hi}; }
            }
        }
    }
};
struct EpiB {
    static constexpr bool PERM = true, AFTER_DRAIN = false, MIDK = false;
    bf16_t* O; const float* LB;
    __device__ __forceinline__ void operator()(const f32x4 (&acc)[2][2][4][2], const Unit& u, int wr, int wc, int fr, int fq) const {
        asm volatile("" : "+v"(fr), "+v"(fq));
        const int row0 = u.pm * BM + wr * 64 + fr, col0 = u.pn * BM + wc * 32 + 8 * fq;
        const int kind = u.pn < 4 ? 0 : (u.pn < 12 ? 1 : 2);
#pragma unroll
        for (int bj = 0; bj < 2; ++bj) {
            float lb[8];
#pragma unroll
            for (int e = 0; e < 8; ++e) lb[e] = kind == 1 ? LB[(col0 + bj * HALF + e) & 1023] : 0.f;
#pragma unroll
            for (int ai = 0; ai < 2; ++ai)
#pragma unroll
                for (int m = 0; m < 4; ++m) {
                    const int r = row0 + ai * HALF + m * 16; int b, p;
                    if (r < 1024) { b = r >> 8; p = r & 255; } else { const int rr = r - 1024, t = rr & 8191; b = rr >> 13; p = 256 + (t & 63) * 128 + (t >> 6); }
                    const int hh = (u.pn & 3) * 2 + bj, part = u.pn >> 2;
                    bf16_t* rowp = O + ((((size_t)(b * 8 + hh) * 8448 + p) * 4 + part) * 128 + wc * 32 + 8 * fq);
                    float v[8];
#pragma unroll
                    for (int e = 0; e < 4; ++e) { v[e] = acc[ai][bj][m][0][e]; v[4 + e] = acc[ai][bj][m][1][e]; }
                    if (kind == 0) {
#pragma unroll
                        for (int e = 0; e < 8; ++e) v[e] = siluf_(v[e]) * 0.08838834764831845f;
                    } else if (kind == 1) {
#pragma unroll
                        for (int e = 0; e < 8; ++e) v[e] = __builtin_amdgcn_logf(lb[e] + (1.f - lb[e]) * sigmoidf_(v[e]));
                    }
                    u32x4 w; w.x = cvt_pk_bf16(v[0], v[1]); w.y = cvt_pk_bf16(v[2], v[3]); w.z = cvt_pk_bf16(v[4], v[5]); w.w = cvt_pk_bf16(v[6], v[7]);
                    *(u32x4*)rowp = w; }
        }
    }
};
struct EpiC {
    static constexpr bool PERM = true, AFTER_DRAIN = false, MIDK = false;
    bf16_t* G; const bf16_t* OA; bf16_t* OAN; bf16_t* OB; const float* wa; const float* wb; PG8_LAS float* P;
    __device__ __forceinline__ void operator()(const f32x4 (&acc)[2][2][4][2], const Unit& u, int wr, int wc, int fr, int fq) const {
        asm volatile("" : "+v"(fr), "+v"(fq));
        const int row0 = u.pm * BM + wr * 64 + fr;
        if (u.pn >= 8) {
            const int col0 = (u.pn - 8) * BM + wc * 32 + 8 * fq;
#pragma unroll
            for (int ai = 0; ai < 2; ++ai)
#pragma unroll
                for (int m = 0; m < 4; ++m) { bf16_t* rowp = G + (size_t)(row0 + ai * HALF + m * 16) * 2048 + col0;
#pragma unroll
                    for (int bj = 0; bj < 2; ++bj) { const f32x4 v0 = acc[ai][bj][m][0], v1 = acc[ai][bj][m][1];
                        u32x4 w; w.x = cvt_pk_bf16(v0[0], v0[1]); w.y = cvt_pk_bf16(v0[2], v0[3]); w.z = cvt_pk_bf16(v1[0], v1[1]); w.w = cvt_pk_bf16(v1[2], v1[3]);
                        *(u32x4*)(rowp + bj * HALF) = w; } }
            return;
        }
        const bool isB = (u.pn >> 2) != 0; const float* nw = isB ? wb : wa;
        const int col0 = (u.pn & 3) * BM + wc * 32 + 8 * fq;
        const unsigned BWD = 32768u * 1024u;
        const bf16_t* SRC = isB ? (const bf16_t*)OB : OA;
        const unsigned sb0 = isB ? (unsigned)(2 * (u.pn & 3)) * (8192u * 128u) + wc * 32u + 8u * fq : (unsigned)((2 * (u.pn & 3)) * 4 + wc) * (32768u * 32u) + 8u * fq;
        const unsigned sbj = isB ? 8192u * 128u : 4u * 32768u * 32u;
#pragma unroll
        for (int am = 0; am < 4; ++am) { const int ai = am >> 1, mh = am & 1;
            u32x4 f[2][2], b[2][2];
#pragma unroll
            for (int mm = 0; mm < 2; ++mm) { const unsigned grow = (unsigned)(u.pm * BM + ai * HALF + wr * 64 + (2 * mh + mm) * 16 + fr);
                const unsigned tt = grow & 8191u, rofs = isB ? ((grow >> 13) * (8u * 8192u) + (tt & 63u) * 128u + (tt >> 6)) * 128u : grow * 32u;
#pragma unroll
                for (int bj = 0; bj < 2; ++bj) { const bf16_t* sp = SRC + (sb0 + bj * sbj + rofs); f[mm][bj] = *(const u32x4*)sp; b[mm][bj] = *(const u32x4*)(sp + BWD); } }
#pragma unroll
            for (int mm = 0; mm < 2; ++mm) { const int rl = ai * HALF + wr * 64 + (2 * mh + mm) * 16 + fr;
#pragma unroll
                for (int bj = 0; bj < 2; ++bj) { float ss = 0.f;
#pragma unroll
                    for (int e = 0; e < 4; ++e) { const float x0 = bflo(f[mm][bj][e]) + bflo(b[mm][bj][e]), x1 = bfhi(f[mm][bj][e]) + bfhi(b[mm][bj][e]); ss += x0 * x0 + x1 * x1; }
                    ss += __shfl_xor(ss, 16); ss += __shfl_xor(ss, 32);
                    if (fq == 0) P[(rl * 2 + bj) * 4 + wc] = ss; } }
            asm volatile("" ::: "memory");
        }
        asm volatile("s_waitcnt lgkmcnt(0)" ::: "memory"); __builtin_amdgcn_s_barrier(); asm volatile("" ::: "memory");
#pragma unroll
        for (int am = 0; am < 4; ++am) { const int ai = am >> 1, mh = am & 1;
            u32x4 f[2][2], b[2][2];
#pragma unroll
            for (int mm = 0; mm < 2; ++mm) { const unsigned grow = (unsigned)(u.pm * BM + ai * HALF + wr * 64 + (2 * mh + mm) * 16 + fr);
                const unsigned tt = grow & 8191u, rofs = isB ? ((grow >> 13) * (8u * 8192u) + (tt & 63u) * 128u + (tt >> 6)) * 128u : grow * 32u;
#pragma unroll
                for (int bj = 0; bj < 2; ++bj) { const bf16_t* sp = SRC + (sb0 + bj * sbj + rofs); f[mm][bj] = *(const u32x4*)sp; b[mm][bj] = *(const u32x4*)(sp + BWD); } }
            const f32x4 wlo = *(const f32x4*)(nw + wc * 32 + 8 * fq), whi = *(const f32x4*)(nw + wc * 32 + 8 * fq + 4);
            const float w8[8] = {wlo[0], wlo[1], wlo[2], wlo[3], whi[0], whi[1], whi[2], whi[3]};
#pragma unroll
            for (int mm = 0; mm < 2; ++mm) { const int m = 2 * mh + mm, rl = ai * HALF + wr * 64 + m * 16 + fr; const unsigned grow = (unsigned)(u.pm * BM + rl);
#pragma unroll
                for (int bj = 0; bj < 2; ++bj) {
                    bf16_t* dp = OAN + (grow * 2048u + (isB ? 1024u : 0u) + col0 + bj * HALF);
                    const f32x4 pp = *(const PG8_LAS f32x4*)(P + (rl * 2 + bj) * 4);
                    const float r = rsqrtf(((pp[0] + pp[1]) + (pp[2] + pp[3])) * (1.f / 128.f) + 1e-6f);
                    const f32x4 g0 = acc[ai][bj][m][0], g1 = acc[ai][bj][m][1];
                    float y[8];
#pragma unroll
                    for (int e = 0; e < 4; ++e) { const float gl = e < 2 ? g0[2 * e] : g1[2 * e - 4], gh = e < 2 ? g0[2 * e + 1] : g1[2 * e - 3];
                        y[2 * e] = (bflo(f[mm][bj][e]) + bflo(b[mm][bj][e])) * r * w8[2 * e] * siluf_(gl); y[2 * e + 1] = (bfhi(f[mm][bj][e]) + bfhi(b[mm][bj][e])) * r * w8[2 * e + 1] * siluf_(gh); }
                    u32x4 w; w.x = cvt_pk_bf16(y[0], y[1]); w.y = cvt_pk_bf16(y[2], y[3]); w.z = cvt_pk_bf16(y[4], y[5]); w.w = cvt_pk_bf16(y[6], y[7]);
                    *(u32x4*)dp = w; } }
            asm volatile("" ::: "memory");
        }
    }
};
struct EpiA {
    static constexpr bool PERM = true, AFTER_DRAIN = false, MIDK = false;
    bf16_t* O; float* AB; const float* a_log; const float* dt_bias;
    __device__ __forceinline__ void operator()(const f32x4 (&acc)[2][2][4][2], const Unit& u, int wr, int wc, int fr, int fq) const {
        asm volatile("" : "+v"(fr), "+v"(fq));
        const int row0 = u.pm * BM + wr * 64 + fr;
        if (u.pn < 12) {
            const int col0 = u.pn * BM + wc * 32 + 8 * fq;
#pragma unroll
            for (int ai = 0; ai < 2; ++ai)
#pragma unroll
                for (int m = 0; m < 4; ++m) { bf16_t* rowp = O + (size_t)(row0 + ai * HALF + m * 16) * 3072 + col0;
#pragma unroll
                    for (int bj = 0; bj < 2; ++bj) { const f32x4 v0 = acc[ai][bj][m][0], v1 = acc[ai][bj][m][1];
                        u32x4 w; w.x = cvt_pk_bf16(v0[0], v0[1]); w.y = cvt_pk_bf16(v0[2], v0[3]); w.z = cvt_pk_bf16(v1[0], v1[1]); w.w = cvt_pk_bf16(v1[2], v1[3]);
                        *(u32x4*)(rowp + bj * HALF) = w; } }
        } else if (wc == 0) {
            float al[8], db[8];
#pragma unroll
            for (int hh = 0; hh < 8; ++hh) { al[hh] = fq < 2 ? __expf(a_log[fq * 8 + hh]) : 0.f; db[hh] = fq < 2 ? dt_bias[fq * 8 + hh] : 0.f; }
#pragma unroll
            for (int ai = 0; ai < 2; ++ai)
#pragma unroll
                for (int m = 0; m < 4; ++m) { float* rowp = AB + (size_t)(row0 + ai * HALF + m * 16) * 32 + 8 * fq;
#pragma unroll
                    for (int n = 0; n < 2; ++n) { const f32x4 v = acc[ai][0][m][n]; f32x4 o;
#pragma unroll
                        for (int i = 0; i < 4; ++i) o[i] = fq < 2 ? -al[4 * n + i] * softplusf_(v[i] + db[4 * n + i]) : sigmoidf_(v[i]);
                        *(f32x4*)(rowp + 4 * n) = o; } }
        }
    }
};
struct EpiGate {
    static constexpr bool PERM = true, AFTER_DRAIN = false, MIDK = false;
    bf16_t* O; const bf16_t* G; int goff; const bf16_t* ADD;
    __device__ __forceinline__ void operator()(const f32x4 (&acc)[2][2][4][2], const Unit& u, int wr, int wc, int fr, int fq) const {
        asm volatile("" : "+v"(fr), "+v"(fq));
        const int row0 = u.pm * BM + wr * 64 + fr, col0 = u.pn * BM + wc * 32 + 8 * fq;
#pragma unroll
        for (int ai = 0; ai < 2; ++ai) {
            u32x4 g[4][2], a[4][2];
#pragma unroll
            for (int m = 0; m < 4; ++m)
#pragma unroll
                for (int bj = 0; bj < 2; ++bj) { const size_t row = (size_t)(row0 + ai * HALF + m * 16); const int col = col0 + bj * HALF;
                    g[m][bj] = *(const u32x4*)(G + row * 2048 + goff + col);
                    a[m][bj] = ADD ? *(const u32x4*)(ADD + row * 1024 + col) : (u32x4){0u, 0u, 0u, 0u}; }
#pragma unroll
            for (int m = 0; m < 4; ++m)
#pragma unroll
                for (int bj = 0; bj < 2; ++bj) { const size_t row = (size_t)(row0 + ai * HALF + m * 16); const int col = col0 + bj * HALF;
                    const u32x4 gg = g[m][bj], aa = a[m][bj];
                    const f32x4 v0 = acc[ai][bj][m][0], v1 = acc[ai][bj][m][1];
                    float r[8];
                    r[0] = sigmoidf_(bflo(gg.x)) * v0[0] + bflo(aa.x); r[1] = sigmoidf_(bfhi(gg.x)) * v0[1] + bfhi(aa.x);
                    r[2] = sigmoidf_(bflo(gg.y)) * v0[2] + bflo(aa.y); r[3] = sigmoidf_(bfhi(gg.y)) * v0[3] + bfhi(aa.y);
                    r[4] = sigmoidf_(bflo(gg.z)) * v1[0] + bflo(aa.z); r[5] = sigmoidf_(bfhi(gg.z)) * v1[1] + bfhi(aa.z);
                    r[6] = sigmoidf_(bflo(gg.w)) * v1[2] + bflo(aa.w); r[7] = sigmoidf_(bfhi(gg.w)) * v1[3] + bfhi(aa.w);
                    u32x4 w; w.x = cvt_pk_bf16(r[0], r[1]); w.y = cvt_pk_bf16(r[2], r[3]); w.z = cvt_pk_bf16(r[4], r[5]); w.w = cvt_pk_bf16(r[6], r[7]);
                    *(u32x4*)(O + row * 1024 + col) = w; }
            asm volatile("" ::: "memory");
        }
    }
};
struct EpiResid {
    static constexpr bool PERM = true, AFTER_DRAIN = false, MIDK = false;
    bf16_t* O; const float* X; const float* MOD;
    __device__ __forceinline__ void operator()(const f32x4 (&acc)[2][2][4][2], const Unit& u, int wr, int wc, int fr, int fq) const {
        asm volatile("" : "+v"(fr), "+v"(fq));
        const int row0 = u.pm * BM + wr * 64 + fr, col0 = u.pn * BM + wc * 32 + 8 * fq;
        const float* g1 = MOD + (size_t)((u.pm * BM) >> 13) * 6144 + 2048;
        f32x4 gv[2][2];
#pragma unroll
        for (int bj = 0; bj < 2; ++bj) { gv[bj][0] = *(const f32x4*)(g1 + col0 + bj * HALF); gv[bj][1] = *(const f32x4*)(g1 + col0 + bj * HALF + 4); }
#pragma unroll
        for (int ai = 0; ai < 2; ++ai)
#pragma unroll
            for (int mh = 0; mh < 2; ++mh) {
                f32x4 xv[2][2][2];
#pragma unroll
                for (int mm = 0; mm < 2; ++mm)
#pragma unroll
                    for (int bj = 0; bj < 2; ++bj) { const size_t off = (size_t)(row0 + ai * HALF + (2 * mh + mm) * 16) * 1024 + col0 + bj * HALF;
                        xv[mm][bj][0] = *(const f32x4*)(X + off); xv[mm][bj][1] = *(const f32x4*)(X + off + 4); }
#pragma unroll
                for (int mm = 0; mm < 2; ++mm)
#pragma unroll
                    for (int bj = 0; bj < 2; ++bj) { const int m = 2 * mh + mm; const size_t off = (size_t)(row0 + ai * HALF + m * 16) * 1024 + col0 + bj * HALF;
                        const f32x4 y0 = xv[mm][bj][0] + gv[bj][0] * acc[ai][bj][m][0], y1 = xv[mm][bj][1] + gv[bj][1] * acc[ai][bj][m][1];
                        *(u32x4*)(O + off) = (u32x4){cvt_pk_bf16(y0[0], y0[1]), cvt_pk_bf16(y0[2], y0[3]), cvt_pk_bf16(y1[0], y1[1]), cvt_pk_bf16(y1[2], y1[3])}; }
                asm volatile("" ::: "memory");
            }
    }
};
struct EpiMerge {
    static constexpr bool PERM = true, AFTER_DRAIN = false, MIDK = true;
    bf16_t* O; const bf16_t* G;
    __device__ __forceinline__ void midk(f32x4 (&acc)[2][2][4][2], const Unit& u, int wr, int wc, int fr, int fq) const {
        asm volatile("" : "+v"(fr), "+v"(fq));
        const int row0 = u.pm * BM + wr * 64 + fr, col0 = u.pn * BM + wc * 32 + 8 * fq;
#pragma unroll
        for (int ai = 0; ai < 2; ++ai) {
            u32x4 ga[4][2], gb[4][2];
#pragma unroll
            for (int m = 0; m < 4; ++m)
#pragma unroll
                for (int bj = 0; bj < 2; ++bj) { const bf16_t* gp = G + (size_t)(row0 + ai * HALF + m * 16) * 2048 + col0 + bj * HALF; ga[m][bj] = *(const u32x4*)gp; gb[m][bj] = *(const u32x4*)(gp + 1024); }
#pragma unroll
            for (int m = 0; m < 4; ++m)
#pragma unroll
                for (int bj = 0; bj < 2; ++bj)
#pragma unroll
                    for (int e = 0; e < 4; ++e) {
                        const float ea0 = __builtin_amdgcn_exp2f(bflo(ga[m][bj][e]) * -1.44269504089f), ea1 = __builtin_amdgcn_exp2f(bfhi(ga[m][bj][e]) * -1.44269504089f);
                        const float eb0 = __builtin_amdgcn_exp2f(fminf(bflo(gb[m][bj][e]) * -1.44269504089f, 60.f)), eb1 = __builtin_amdgcn_exp2f(fminf(bfhi(gb[m][bj][e]) * -1.44269504089f, 60.f));
                        const float r0 = (1.f + eb0) * __builtin_amdgcn_rcpf(1.f + ea0), r1 = (1.f + eb1) * __builtin_amdgcn_rcpf(1.f + ea1);
                        if (e < 2) { acc[ai][bj][m][0][2 * e] *= r0; acc[ai][bj][m][0][2 * e + 1] *= r1; } else { acc[ai][bj][m][1][2 * e - 4] *= r0; acc[ai][bj][m][1][2 * e - 3] *= r1; }
                    }
            asm volatile("" ::: "memory");
        }
    }
    __device__ __forceinline__ void operator()(const f32x4 (&acc)[2][2][4][2], const Unit& u, int wr, int wc, int fr, int fq) const {
        asm volatile("" : "+v"(fr), "+v"(fq));
        const int row0 = u.pm * BM + wr * 64 + fr, col0 = u.pn * BM + wc * 32 + 8 * fq;
#pragma unroll
        for (int ai = 0; ai < 2; ++ai) {
            u32x4 g[4][2];
#pragma unroll
            for (int m = 0; m < 4; ++m)
#pragma unroll
                for (int bj = 0; bj < 2; ++bj) g[m][bj] = *(const u32x4*)(G + (size_t)(row0 + ai * HALF + m * 16) * 2048 + 1024 + col0 + bj * HALF);
#pragma unroll
            for (int m = 0; m < 4; ++m)
#pragma unroll
                for (int bj = 0; bj < 2; ++bj) { const u32x4 gg = g[m][bj]; const f32x4 v0 = acc[ai][bj][m][0], v1 = acc[ai][bj][m][1];
                    u32x4 w; w.x = cvt_pk_bf16(sigmoidf_(bflo(gg.x)) * v0[0], sigmoidf_(bfhi(gg.x)) * v0[1]); w.y = cvt_pk_bf16(sigmoidf_(bflo(gg.y)) * v0[2], sigmoidf_(bfhi(gg.y)) * v0[3]);
                    w.z = cvt_pk_bf16(sigmoidf_(bflo(gg.z)) * v1[0], sigmoidf_(bfhi(gg.z)) * v1[1]); w.w = cvt_pk_bf16(sigmoidf_(bflo(gg.w)) * v1[2], sigmoidf_(bfhi(gg.w)) * v1[3]);
                    *(u32x4*)(O + (size_t)(row0 + ai * HALF + m * 16) * 1024 + col0 + bj * HALF) = w; }
            asm volatile("" ::: "memory");
        }
    }
};
}

__device__ __forceinline__ void p0_transpose_item(const float* W, int pitch, int ncols, int K, bf16* WT, LAS float* scr, int item, int lane, int ldk = 0) {
    if (ldk == 0) ldk = K;
    const int nblk = ncols / 32, kb = item / nblk, nb = item % nblk, k0 = 64 * kb, n0 = 32 * nb;
#pragma unroll 8
    for (int i = 0; i < 32; ++i) { const int kk = 2 * i + (lane >> 5); scr[kk * 33 + (lane & 31)] = W[(size_t)(k0 + kk) * pitch + n0 + (lane & 31)]; }
    LDS_WAIT(); asm volatile("" ::: "memory");
    const int c = lane & 7;
#pragma unroll
    for (int j = 0; j < 4; ++j) { const int n = (lane >> 3) + 8 * j; const LAS float* s = scr + (8 * c) * 33 + n;
        v4u o; o.x = pk2(s[0 * 33], s[1 * 33]); o.y = pk2(s[2 * 33], s[3 * 33]); o.z = pk2(s[4 * 33], s[5 * 33]); o.w = pk2(s[6 * 33], s[7 * 33]);
        *(v4u*)(WT + (size_t)(n0 + n) * ldk + k0 + 8 * c) = o; }
    LDS_WAIT(); asm volatile("" ::: "memory");
}
__device__ __forceinline__ void p0_prologue(Frame& F) {
    {
        LAS float* sc = (LAS float*)F.lds;
        LAS float* red = (LAS float*)(F.lds + 32768);
        if ((int)blockIdx.x < 96) {
            for (int i = F.tid; i < 5120; i += NT) { const int r = i >> 10, k = i & 1023; const float v = r < 4 ? F.c[r * 1024 + k] : F.c_ctx[k]; sc[i] = siluf_(v); }
            __syncthreads();
            float* MOD = (float*)(F.ws + WS_MOD);
            for (int grp = blockIdx.x; grp < 96; grp += F.G) {
                const int col = grp * 64 + F.lane, ks = F.wave;
                float acc[5] = {0.f, 0.f, 0.f, 0.f, 0.f};
                for (int k = ks * 128; k < ks * 128 + 128; ++k) { const float w = F.w_ada[(size_t)k * 6144 + col];
#pragma unroll
                    for (int r = 0; r < 5; ++r) acc[r] = fmaf(sc[r * 1024 + k], w, acc[r]); }
#pragma unroll
                for (int r = 0; r < 5; ++r) red[(ks * 5 + r) * 64 + F.lane] = acc[r];
                __syncthreads();
                if (F.tid < 320) { const int r = F.tid >> 6; float s = 0.f;
#pragma unroll
                    for (int q = 0; q < 8; ++q) s += red[(q * 5 + r) * 64 + F.lane];
                    MOD[r * 6144 + col] = s + F.b_ada[col]; }
                __syncthreads();
            }
        }
        if (blockIdx.x == 96) { float* LB = (float*)(F.ws + WS_LB); for (int i = F.tid; i < 1024; i += NT) LB[i] = sigmoidf_(F.lb_logits[i] - F.lb_logits[1024 + i]); }
    }
    LAS float* scr = (LAS float*)(F.lds + 49152 + F.wave * 8448);
    const int gw = blockIdx.x * NWAVES + F.wave, NGW = F.G * NWAVES;
    bf16* WTA = (bf16*)(F.ws + WS_WTA); bf16* WTB = (bf16*)(F.ws + WS_WTB); bf16* WTC = (bf16*)(F.ws + WS_WTC);
    constexpr int I0 = 16 * 96, I1 = 16 * 1, I2 = 16 * 128, I3 = 16 * 32, I4 = 16 * 32, I5 = 16 * 64, I6 = 16 * 32, I7 = 16 * 32, I8 = 16 * 32, I9 = 16 * 64;
    constexpr int NITEMS = I0 + I1 + I2 + I3 + I4 + I5 + I6 + I7 + I8 + I9;
    for (int it = gw; it < I0 + I1 + I2; it += NGW) {
        int r = it;
        if (r < I0) { p0_transpose_item(F.w_in + C_QKV, NIN, 3072, D, WTA, scr, r, F.lane); continue; } r -= I0;
        if (r < I1) { p0_transpose_item(F.w_in + C_AB, NIN, 32, D, WTA + (size_t)3072 * D, scr, r, F.lane); continue; } r -= I1;
        p0_transpose_item(F.w_in + C_QB, NIN, 4096, D, WTB, scr, r, F.lane);
    }
    { v4u* z = (v4u*)(WTA + (size_t)3104 * D); for (int i = blockIdx.x * NT + F.tid; i < 28672; i += F.G * NT) z[i] = (v4u){0u, 0u, 0u, 0u}; }
}

__device__ __forceinline__ void norm_mod_row_bf16(const float* src, const float* w, const float* shift, const float* scale, bf16* dst, int lane) {
    const f32x4* xr = (const f32x4*)src + lane; f32x4 v[4]; float s = 0.f;
#pragma unroll
    for (int j = 0; j < 4; ++j) { v[j] = xr[64 * j]; s += (v[j].x * v[j].x + v[j].y * v[j].y) + (v[j].z * v[j].z + v[j].w * v[j].w); }
    const float r = rsqrtf(wave_sum(s) * (1.f / D) + EPS);
    unsigned long long* o8 = (unsigned long long*)dst + lane;
#pragma unroll
    for (int j = 0; j < 4; ++j) { const f32x4 ww = ((const f32x4*)w)[64 * j + lane], sh = ((const f32x4*)shift)[64 * j + lane], sc = ((const f32x4*)scale)[64 * j + lane];
        const f32x4 y = v[j] * r * ww * (sc + 1.f) + sh;
        o8[64 * j] = (unsigned long long)pk2(y.x, y.y) | ((unsigned long long)pk2(y.z, y.w) << 32); }
}
__device__ __forceinline__ void p1_h(Frame& F) {
    const int gw = blockIdx.x * NWAVES + F.wave, NGW = F.G * NWAVES;
    const float* MOD = (const float*)(F.ws + WS_MOD); bf16* H = (bf16*)(F.ws + WS_H);
    for (int r = gw; r < NROW; r += NGW) {
        const float* src; const float* md;
        if (r < NCTX) { src = F.ctx + (size_t)r * D; md = MOD + 4 * 6144; } else { src = F.x + (size_t)(r - NCTX) * D; md = MOD + (size_t)((r - NCTX) >> 13) * 6144; }
        norm_mod_row_bf16(src, F.norm1_w, md, md + 1024, H + (size_t)r * D, F.lane);
    }
}

typedef short s16x4 __attribute__((ext_vector_type(4)));
__device__ __forceinline__ bf16x8 ld_row(const LAS unsigned char* img, int pitch, int r0, int k0, int lane) {
    return *(const LAS bf16x8*)(img + (r0 + (lane & 15)) * pitch + (k0 + 8 * (lane >> 4)) * 2);
}
__device__ __forceinline__ bf16x8 ld_tr(const LAS unsigned char* img, int pitch, int k0, int n0, int lane) {
    const int g = lane >> 4, q = (lane >> 2) & 3, p = lane & 3;
    const LAS unsigned char* a0 = img + (k0 + 8 * g + q) * pitch + (n0 + 4 * p) * 2;
    const s16x4 lo = __builtin_amdgcn_ds_read_tr16_b64_v4i16((LAS s16x4*)a0);
    const s16x4 hi = __builtin_amdgcn_ds_read_tr16_b64_v4i16((LAS s16x4*)(a0 + 4 * pitch));
    bf16x8 r; r[0] = lo[0]; r[1] = lo[1]; r[2] = lo[2]; r[3] = lo[3]; r[4] = hi[0]; r[5] = hi[1]; r[6] = hi[2]; r[7] = hi[3];
    return r;
}
#define MFMA16(a, b, c) __builtin_amdgcn_mfma_f32_16x16x32_bf16((a), (b), (c), 0, 0, 0)


#define LDS_BARRIER() do { asm volatile("s_waitcnt lgkmcnt(0)" ::: "memory"); __builtin_amdgcn_s_barrier(); asm volatile("" ::: "memory"); } while (0)
__device__ __forceinline__ void p2b_gdn_prep(Frame& F) {
    const bf16* QKV = (const bf16*)(F.ws + WS_R1); bf16* QKVC = (bf16*)(F.ws + WS_QKVC); const float* conv_w = late_arg(8);
    const int gw = blockIdx.x * NWAVES + F.wave, NGW = F.G * NWAVES, lane = F.lane;
    for (int item = gw; item < (NROW / 64) * 6; item += NGW) {
        const int rb = item / 6, c6 = item - rb * 6, row0 = rb * 64, ch0 = c6 * 512 + lane * 8;
        int seg0, seg1;
        if (row0 < NCTX) { seg0 = row0 & ~(CTX - 1); seg1 = seg0 + CTX; } else { seg0 = NCTX + ((row0 - NCTX) & ~(SEQ - 1)); seg1 = seg0 + SEQ; }
        float cw[3][8];
#pragma unroll
        for (int j = 0; j < 3; ++j) { const f32x4 a = *(const f32x4*)(conv_w + j * 3072 + ch0), b = *(const f32x4*)(conv_w + j * 3072 + ch0 + 4);
            cw[j][0] = a.x; cw[j][1] = a.y; cw[j][2] = a.z; cw[j][3] = a.w; cw[j][4] = b.x; cw[j][5] = b.y; cw[j][6] = b.z; cw[j][7] = b.w; }
        const v4u zero4 = (v4u){0u, 0u, 0u, 0u};
        const float nscale = c6 < 2 ? QSCALE : 1.f;
        v4u win[10];
        win[0] = row0 > seg0 ? *(const v4u*)(QKV + (size_t)(row0 - 1) * 3072 + ch0) : zero4;
        win[1] = *(const v4u*)(QKV + (size_t)row0 * 3072 + ch0);
        for (int g = 0; g < 8; ++g) {
#pragma unroll
            for (int e = 0; e < 8; ++e) { const int row = row0 + 8 * g + e + 1; win[2 + e] = row < seg1 ? *(const v4u*)(QKV + (size_t)row * 3072 + ch0) : zero4; }
#pragma unroll
            for (int rr = 0; rr < 8; ++rr) {
                const int row = row0 + 8 * g + rr;
                const v4u prev = win[rr], cur = win[rr + 1], nxt = win[rr + 2];
                float y[8]; float ss = 0.f;
#pragma unroll
                for (int e = 0; e < 4; ++e) {
                    const unsigned pw = prev[e], cwd = cur[e], nw = nxt[e];
                    const float a0 = cw[0][2 * e] * bflo(pw) + cw[1][2 * e] * bflo(cwd) + cw[2][2 * e] * bflo(nw);
                    const float a1 = cw[0][2 * e + 1] * bfhi(pw) + cw[1][2 * e + 1] * bfhi(cwd) + cw[2][2 * e + 1] * bfhi(nw);
                    y[2 * e] = siluf_(a0); y[2 * e + 1] = siluf_(a1);
                    ss += y[2 * e] * y[2 * e] + y[2 * e + 1] * y[2 * e + 1];
                }
                float sc = 1.f;
                if (c6 < 4) {
                    ss += __shfl_xor(ss, 1); ss += __shfl_xor(ss, 2); ss += __shfl_xor(ss, 4); ss += __shfl_xor(ss, 8);
                    sc = rsqrtf(ss + EPS) * nscale;
                }
                v4u o; o.x = pk2(y[0] * sc, y[1] * sc); o.y = pk2(y[2] * sc, y[3] * sc); o.z = pk2(y[4] * sc, y[5] * sc); o.w = pk2(y[6] * sc, y[7] * sc);
                { int bb, tp; if (row < NCTX) { bb = row >> 8; tp = row & 255; } else { const int rr = row - NCTX; bb = rr >> 13; tp = 256 + (rr & 8191); }
                  const int part = ch0 >> 10, hd = (ch0 >> 7) & 7, cc = ch0 & 127;
                  *(v4u*)(QKVC + ((((size_t)(bb * 8 + hd) * 8448 + tp) * 3 + part) * 128 + cc)) = o; }
            }
            win[0] = win[8]; win[1] = win[9];
        }
    }
}

__device__ __forceinline__ size_t gdn_row(int b, int dir, int ci, int i) {
    const int seg = ci < 4 ? 0 : 1, cs = seg == 0 ? ci : ci - 4, nch = seg == 0 ? 4 : 128, lo = (dir == 0 ? cs : nch - 1 - cs) * 64;
    return (seg == 0 ? (size_t)b * CTX : (size_t)NCTX + (size_t)b * SEQ) + (dir == 0 ? lo + i : lo + 63 - i);
}
__device__ __forceinline__ int gdn_pos(int dir, int ci, int i) {
    const int seg = ci < 4 ? 0 : 1, cs = seg == 0 ? ci : ci - 4, nch = seg == 0 ? 4 : 128, lo = (dir == 0 ? cs : nch - 1 - cs) * 64;
    return seg * 256 + (dir == 0 ? lo + i : lo + 63 - i);
}
__device__ __forceinline__ void p3a_gdn_tw(Frame& F) {
    constexpr int PK = 272, PP = 144;
    constexpr int GRP_BYTES = 2 * 64 * PK + 3 * 64 * PP + 4096 + 512;
    const int tid = F.tid, lane = F.lane, w = F.wave, fr = lane & 15, fq = lane >> 4;
    const int g = w >> 2, wl = w & 3, tg = tid & 255;
    LAS unsigned char* base = F.lds + g * GRP_BYTES;
    LAS unsigned char* Kb = base;
    LAS unsigned char* KBG = Kb + 64 * PK;
    LAS unsigned char* Wn = Kb;
    LAS unsigned char* Mb = KBG + 64 * PK;
    LAS unsigned char* Tm = Mb + 64 * PP;
    LAS unsigned char* TMP = Tm + 64 * PP;
    LAS float* Md = (LAS float*)(TMP + 64 * PP);
    LAS float* gcs = Md + 1024;
    LAS float* bet = gcs + 64;
    const bf16* QKVC = (const bf16*)(F.ws + WS_QKVC); const float* AB = (const float*)(F.ws + WS_AB);
    unsigned char* TW = F.ws + WS_R1;
    const int li = tg >> 2, seg4 = tg & 3;
    __syncthreads();
    for (int i = tg; i < 64 * PP / 4; i += 256) ((LAS unsigned*)TMP)[i] = 0u;
    v4u k0, k1, k2, k3; float gi = 0.f, bi = 0.f;
#define TW_LOAD(cp_) do { const int ch_ = (cp_) / 132, ci_ = (cp_) - ch_ * 132, b_ = ch_ >> 4, h_ = (ch_ >> 1) & 7, dir_ = ch_ & 1; \
        { const bf16* rp_ = QKVC + (((size_t)(b_ * 8 + h_) * 8448 + gdn_pos(dir_, ci_, li)) * 3 + 1) * 128 + seg4 * 32; k0 = *(const v4u*)rp_; k1 = *(const v4u*)(rp_ + 8); k2 = *(const v4u*)(rp_ + 16); k3 = *(const v4u*)(rp_ + 24); } \
        if (wl == 0) { const size_t row_ = gdn_row(b_, dir_, ci_, lane); gi = AB[row_ * 32 + dir_ * 8 + h_]; bi = AB[row_ * 32 + 16 + dir_ * 8 + h_]; } } while (0)
    constexpr int NPAIR = 8448 / 2;
    if ((int)blockIdx.x < NPAIR) TW_LOAD(2 * (int)blockIdx.x + g);
    for (int pr = blockIdx.x; pr < NPAIR; pr += F.G) {
        const int cp = 2 * pr + g;
        if (wl == 0) {
            float x = gi;
#pragma unroll
            for (int o = 1; o < 64; o <<= 1) { const float y = __shfl_up(x, o); if (lane >= o) x += y; }
            gcs[lane] = x; bet[lane] = bi;
        }
        for (int i = tg; i < 64 * PP / 16; i += 256) ((LAS v4u*)Tm)[i] = (v4u){0u, 0u, 0u, 0u};
        __syncthreads();
        {
            const float fac = bet[li] * __expf(gcs[li]);
            const int o = li * PK + seg4 * 64;
            *(LAS v4u*)(Kb + o) = k0; *(LAS v4u*)(Kb + o + 16) = k1; *(LAS v4u*)(Kb + o + 32) = k2; *(LAS v4u*)(Kb + o + 48) = k3;
#define SC4(k_) ((v4u){pk2(bflo(k_.x) * fac, bfhi(k_.x) * fac), pk2(bflo(k_.y) * fac, bfhi(k_.y) * fac), pk2(bflo(k_.z) * fac, bfhi(k_.z) * fac), pk2(bflo(k_.w) * fac, bfhi(k_.w) * fac)})
            *(LAS v4u*)(KBG + o) = SC4(k0); *(LAS v4u*)(KBG + o + 16) = SC4(k1); *(LAS v4u*)(KBG + o + 32) = SC4(k2); *(LAS v4u*)(KBG + o + 48) = SC4(k3);
#undef SC4
        }
        __syncthreads();
        if (pr + F.G < NPAIR) TW_LOAD(2 * (pr + F.G) + g);
#pragma unroll
        for (int q = 0; q < 3; ++q) {
            const int tq = wl + 4 * q;
            if (tq < 10) {
                const int it = tq < 4 ? 3 : tq < 7 ? 2 : tq < 9 ? 1 : 0, jt = tq < 4 ? tq : tq < 7 ? tq - 4 : tq < 9 ? tq - 7 : 0;
                f32x4 accK = (f32x4){0.f, 0.f, 0.f, 0.f};
#pragma unroll
                for (int ks = 0; ks < 4; ++ks) accK = MFMA16(ld_row(Kb, PK, it * 16, ks * 32, lane), ld_row(Kb, PK, jt * 16, ks * 32, lane), accK);
                const float gj = gcs[jt * 16 + fr];
#pragma unroll
                for (int r = 0; r < 4; ++r) {
                    const int il = 4 * fq + r;
                    const float gr = gcs[it * 16 + il], br = bet[it * 16 + il];
                    const bool lower = jt < it || il > fr;
                    const float m = lower ? br * accK[r] * __expf(gr - gj) : 0.f;
                    *(LAS unsigned short*)(Mb + (it * 16 + il) * PP + (jt * 16 + fr) * 2) = (unsigned short)f2bf(m);
                    if (jt == it) Md[(it * 16 + il) * 16 + fr] = m;
                }
            }
        }
        __syncthreads();
        if (wl == 0) {
            const int bk = lane >> 4, c = lane & 15;
            float x[16];
#pragma unroll
            for (int r = 0; r < 16; ++r) x[r] = r == c ? 1.f : 0.f;
#pragma unroll
            for (int m = 0; m < 15; ++m) {
#pragma unroll
                for (int r = m + 1; r < 16; ++r) x[r] = fmaf(-Md[(bk * 16 + r) * 16 + m], x[m], x[r]);
            }
#pragma unroll
            for (int r = 0; r < 16; ++r) *(LAS unsigned short*)(Tm + (bk * 16 + r) * PP + (bk * 16 + c) * 2) = (unsigned short)f2bf(x[r]);
        }
        __syncthreads();
        if (wl < 2) {
            const int o32 = 32 * wl;
            const f32x4 acc = MFMA16(ld_row(Mb, PP, o32 + 16, o32, lane), ld_tr(Tm, PP, o32, o32, lane), ((f32x4){0.f, 0.f, 0.f, 0.f}));
#pragma unroll
            for (int r = 0; r < 4; ++r) *(LAS unsigned short*)(TMP + (o32 + 16 + 4 * fq + r) * PP + (o32 + fr) * 2) = (unsigned short)f2bf(acc[r]);
        }
        __syncthreads();
        if (wl < 2) {
            const int o32 = 32 * wl;
            const f32x4 acc = MFMA16(ld_row(Tm, PP, o32 + 16, o32, lane), ld_tr(TMP, PP, o32, o32, lane), ((f32x4){0.f, 0.f, 0.f, 0.f}));
#pragma unroll
            for (int r = 0; r < 4; ++r) *(LAS unsigned short*)(Tm + (o32 + 16 + 4 * fq + r) * PP + (o32 + fr) * 2) = (unsigned short)f2bf(-acc[r]);
        }
        __syncthreads();
        {
            const int yi = wl >> 1, yj = wl & 1;
            const f32x4 acc = MFMA16(ld_row(Mb, PP, 32 + 16 * yi, 0, lane), ld_tr(Tm, PP, 0, 16 * yj, lane), ((f32x4){0.f, 0.f, 0.f, 0.f}));
#pragma unroll
            for (int r = 0; r < 4; ++r) *(LAS unsigned short*)(TMP + (32 + 16 * yi + 4 * fq + r) * PP + (16 * yj + fr) * 2) = (unsigned short)f2bf(acc[r]);
        }
        __syncthreads();
        {
            const int yi = wl >> 1, yj = wl & 1;
            const f32x4 acc = MFMA16(ld_row(Tm, PP, 32 + 16 * yi, 32, lane), ld_tr(TMP, PP, 32, 16 * yj, lane), ((f32x4){0.f, 0.f, 0.f, 0.f}));
#pragma unroll
            for (int r = 0; r < 4; ++r) *(LAS unsigned short*)(Tm + (32 + 16 * yi + 4 * fq + r) * PP + (16 * yj + fr) * 2) = (unsigned short)f2bf(-acc[r]);
        }
        __syncthreads();
        {
            const int it = wl;
            bf16x8 at[2];
            at[0] = ld_row(Tm, PP, it * 16, 0, lane); at[1] = ld_row(Tm, PP, it * 16, 32, lane);
            const int nks = it >= 2 ? 2 : 1;
#pragma unroll
            for (int dt = 0; dt < 8; ++dt) {
                f32x4 acc = (f32x4){0.f, 0.f, 0.f, 0.f};
#pragma unroll
                for (int ks = 0; ks < 2; ++ks) if (ks < nks) acc = MFMA16(at[ks], ld_tr(KBG, PK, ks * 32, dt * 16, lane), acc);
#pragma unroll
                for (int r = 0; r < 4; ++r) *(LAS unsigned short*)(Wn + (it * 16 + 4 * fq + r) * PK + (dt * 16 + fr) * 2) = (unsigned short)f2bf(-acc[r]);
            }
        }
        __syncthreads();
        {
            if (tg < 128) ((float*)(F.ws + WS_GCB))[(size_t)cp * 128 + tg] = gcs[tg];
            unsigned char* dst = TW + (size_t)cp * 24576;
            *(v4u*)(dst + li * 128 + seg4 * 32) = *(const LAS v4u*)(Tm + li * PP + seg4 * 32);
            *(v4u*)(dst + li * 128 + seg4 * 32 + 16) = *(const LAS v4u*)(Tm + li * PP + seg4 * 32 + 16);
#pragma unroll
            for (int q = 0; q < 4; ++q) *(v4u*)(dst + 8192 + li * 256 + seg4 * 64 + 16 * q) = *(const LAS v4u*)(Wn + li * PK + seg4 * 64 + 16 * q);
        }
        __syncthreads();
    }
#undef TW_LOAD
}

struct GdnCtx { LAS unsigned char *Kb, *Qb, *Wn, *VB, *Tm, *QKd, *St, *Vt, *Vst; LAS float *gcs, *bet; const bf16* QKVC; const float* GCB; const unsigned char* TW; bf16* OA; bf16* JUNK;
                int lane, w, fr, fq, li, seg8, it, half, b, h, dir, sl, chain; };
struct GdnRegs { v4u q0, q1, k0, k1, t0, w0, w1; v2u vv; float gi, bi; };
__device__ __forceinline__ void gdn_load(const GdnCtx& C, GdnRegs& R, int ci) {
    const bf16* rp = C.QKVC + ((size_t)(C.b * 8 + C.h) * 8448 + gdn_pos(C.dir, ci, C.li)) * 384 + C.seg8 * 16;
    R.q0 = *(const v4u*)rp; R.q1 = *(const v4u*)(rp + 8); R.k0 = *(const v4u*)(rp + 128); R.k1 = *(const v4u*)(rp + 136);
    R.vv = *(const v2u*)(rp + 256 - C.seg8 * 16 + C.sl * 32 + C.seg8 * 4);
    const unsigned char* src = C.TW + (size_t)(C.chain * 132 + ci) * 24576;
    R.t0 = *(const v4u*)(src + C.li * 128 + C.seg8 * 16); R.w0 = *(const v4u*)(src + 8192 + C.li * 256 + C.seg8 * 32); R.w1 = *(const v4u*)(src + 8192 + C.li * 256 + C.seg8 * 32 + 16);
    { const float* gp = C.GCB + (size_t)(C.chain * 132 + ci) * 128; R.bi = gp[64 + C.li]; R.gi = gp[(C.w & 1) * 64 + C.lane]; }
}
__device__ __forceinline__ void gdn_chunk(const GdnCtx& C, GdnRegs& R, f32x4 (&Sacc)[2], int ci) {
    constexpr int PK = 272, PP = 144, PV = 80;
    const int lane = C.lane, w = C.w, fr = C.fr, fq = C.fq, li = C.li, seg8 = C.seg8, it = C.it, half = C.half;
    const int seg = ci < 4 ? 0 : 1, cs = seg == 0 ? ci : ci - 4, nch = seg == 0 ? 4 : 128, lo = (C.dir == 0 ? cs : nch - 1 - cs) * 64;
    if (w < 2) C.gcs[w * 64 + lane] = R.gi;
    {
        const int o = li * PK + seg8 * 32;
        *(LAS v4u*)(C.Qb + o) = R.q0; *(LAS v4u*)(C.Qb + o + 16) = R.q1;
        *(LAS v4u*)(C.Kb + o) = R.k0; *(LAS v4u*)(C.Kb + o + 16) = R.k1;
        *(LAS v4u*)(C.Wn + o) = R.w0; *(LAS v4u*)(C.Wn + o + 16) = R.w1;
        *(LAS v4u*)(C.Tm + li * PP + seg8 * 16) = R.t0;
        const float bti = R.bi;
        *(LAS v2u*)(C.VB + li * PV + seg8 * 8) = (v2u){pk2(bflo(R.vv.x) * bti, bfhi(R.vv.x) * bti), pk2(bflo(R.vv.y) * bti, bfhi(R.vv.y) * bti)};
    }
    LDS_BARRIER();
    gdn_load(C, R, ci + 2 < 132 ? ci + 2 : 131);
    f32x4 acc_o = (f32x4){0.f, 0.f, 0.f, 0.f}, acc_v = acc_o;
    {
        bf16x8 aq[4], kb[2][4], tm[2], vb[2], bs[4], wn[4];
        float gr[4], gj[2];
#pragma unroll
        for (int ks = 0; ks < 4; ++ks) aq[ks] = ld_row(C.Qb, PK, it * 16, ks * 32, lane);
#pragma unroll
        for (int jj = 0; jj < 2; ++jj)
#pragma unroll
            for (int ks = 0; ks < 4; ++ks) kb[jj][ks] = ld_row(C.Kb, PK, (2 * half + jj) * 16, ks * 32, lane);
#pragma unroll
        for (int ks = 0; ks < 2; ++ks) { tm[ks] = ld_row(C.Tm, PP, it * 16, ks * 32, lane); vb[ks] = ld_tr(C.VB, PV, ks * 32, half * 16, lane); }
#pragma unroll
        for (int ks = 0; ks < 4; ++ks) { bs[ks] = ld_row(C.St, PK, half * 16, ks * 32, lane); wn[ks] = ld_row(C.Wn, PK, it * 16, ks * 32, lane); }
#pragma unroll
        for (int r = 0; r < 4; ++r) gr[r] = C.gcs[it * 16 + 4 * fq + r];
        gj[0] = C.gcs[(2 * half) * 16 + fr]; gj[1] = C.gcs[(2 * half + 1) * 16 + fr];
        const float gl = C.gcs[63];
        __builtin_amdgcn_sched_barrier(0);
#pragma unroll
        for (int jj = 0; jj < 2; ++jj) {
            const int jt = 2 * half + jj;
            f32x4 accQ = (f32x4){0.f, 0.f, 0.f, 0.f};
            if (jt <= it) {
#pragma unroll
                for (int ks = 0; ks < 4; ++ks) accQ = MFMA16(aq[ks], kb[jj][ks], accQ);
            }
#pragma unroll
            for (int r = 0; r < 4; ++r) {
                const int il = 4 * fq + r;
                const bool lowereq = jt < it || (jt == it && il >= fr);
                const float qk = lowereq ? accQ[r] * __expf(gr[r] - gj[jj]) : 0.f;
                *(LAS unsigned short*)(C.QKd + (it * 16 + il) * PP + (jt * 16 + fr) * 2) = (unsigned short)f2bf(qk);
            }
        }
        const int nks = it >= 2 ? 2 : 1;
#pragma unroll
        for (int ks = 0; ks < 2; ++ks) if (ks < nks) acc_v = MFMA16(tm[ks], vb[ks], acc_v);
#pragma unroll
        for (int ks = 0; ks < 4; ++ks) { acc_v = MFMA16(wn[ks], bs[ks], acc_v); acc_o = MFMA16(aq[ks], bs[ks], acc_o); }
        float sv[4];
#pragma unroll
        for (int r = 0; r < 4; ++r) { acc_o[r] *= __expf(gr[r]); sv[r] = acc_v[r] * __expf(gl - gr[r]); }
        const int o = (half * 16 + fr) * PP + (it * 16 + 4 * fq) * 2;
        *(LAS v2u*)(C.Vt + o) = (v2u){pk2(acc_v[0], acc_v[1]), pk2(acc_v[2], acc_v[3])};
        *(LAS v2u*)(C.Vst + o) = (v2u){pk2(sv[0], sv[1]), pk2(sv[2], sv[3])};
    }
    LDS_BARRIER();
    {
        const int d0 = 16 * w;
        bf16x8 qd[2], vt[2], kt[2], vs[2][2];
#pragma unroll
        for (int ks = 0; ks < 2; ++ks) { qd[ks] = ld_row(C.QKd, PP, it * 16, ks * 32, lane); vt[ks] = ld_row(C.Vt, PP, half * 16, ks * 32, lane); kt[ks] = ld_tr(C.Kb, PK, ks * 32, d0, lane); }
#pragma unroll
        for (int ct = 0; ct < 2; ++ct)
#pragma unroll
            for (int ks = 0; ks < 2; ++ks) vs[ct][ks] = ld_row(C.Vst, PP, ct * 16, ks * 32, lane);
        const float egl = __expf(C.gcs[63]);
        __builtin_amdgcn_sched_barrier(0);
#pragma unroll
        for (int ks = 0; ks < 2; ++ks) if (2 * ks <= it) acc_o = MFMA16(qd[ks], vt[ks], acc_o);
        {
#pragma unroll
            for (int r = 0; r < 4; ++r) { const int i = it * 16 + 4 * fq + r, t = C.dir == 0 ? lo + i : lo + 63 - i;
                bf16* op = seg == 1 ? C.OA + ((((size_t)C.dir * 8 + C.h) * 4 + C.sl) * NLAT + (size_t)C.b * SEQ + t) * 32 + half * 16 + fr
                                    : C.JUNK + r;
                *op = (bf16)f2bf(acc_o[r]); }
        }
#pragma unroll
        for (int ct = 0; ct < 2; ++ct) {
#pragma unroll
            for (int r = 0; r < 4; ++r) Sacc[ct][r] *= egl;
#pragma unroll
            for (int ks = 0; ks < 2; ++ks) Sacc[ct] = MFMA16(kt[ks], vs[ct][ks], Sacc[ct]);
            *(LAS v2u*)(C.St + (ct * 16 + fr) * PK + (d0 + 4 * fq) * 2) = (v2u){pk2(Sacc[ct][0], Sacc[ct][1]), pk2(Sacc[ct][2], Sacc[ct][3])};
        }
    }
    LDS_BARRIER();
}
__device__ __forceinline__ void p3_gdn_chunk(Frame& F, bf16* OA) {
    constexpr int PK = 272, PP = 144, PV = 80;
    GdnCtx C;
    C.Kb = F.lds; C.Qb = C.Kb + 64 * PK; C.Wn = C.Qb + 64 * PK; C.VB = C.Wn + 64 * PK; C.Tm = C.VB + 64 * PV; C.QKd = C.Tm + 64 * PP; C.St = C.QKd + 64 * PP;
    C.Vt = C.St + 32 * PK; C.Vst = C.Vt + 32 * PP; C.gcs = (LAS float*)(C.Vst + 32 * PP); C.bet = C.gcs + 64;
    C.QKVC = (const bf16*)(F.ws + WS_QKVC); C.GCB = (const float*)(F.ws + WS_GCB); C.TW = F.ws + WS_R1; C.OA = OA; C.JUNK = (bf16*)(F.ws + WS_AB) + (blockIdx.x * NT + F.tid) * 8;
    C.lane = F.lane; C.w = F.wave; C.fr = F.lane & 15; C.fq = F.lane >> 4; C.li = F.tid >> 3; C.seg8 = F.tid & 7; C.it = F.wave >> 1; C.half = F.wave & 1;
    for (int item = blockIdx.x; item < 256; item += F.G) {
        const int xcd = item & 7, idx = item >> 3;
        C.chain = xcd * 8 + (idx >> 2); C.sl = idx & 3; C.b = C.chain >> 4; C.h = (C.chain >> 1) & 7; C.dir = C.chain & 1;
        f32x4 Sacc[2]; Sacc[0] = (f32x4){0.f, 0.f, 0.f, 0.f}; Sacc[1] = Sacc[0];
        __syncthreads();
        for (int i = F.tid; i < 32 * PK / 4; i += NT) ((LAS unsigned*)C.St)[i] = 0u;
        GdnRegs R0, R1;
        R0.gi = R0.bi = R1.gi = R1.bi = 0.f;
        gdn_load(C, R0, 0); gdn_load(C, R1, 1);
        for (int ci = 0; ci < 132; ci += 2) { gdn_chunk(C, R0, Sacc, ci); gdn_chunk(C, R1, Sacc, ci + 1); }
    }
}
typedef float f32x2v __attribute__((ext_vector_type(2)));
#define F2V(a, b) ((f32x2v){(a), (b)})
template <bool B> struct HgTag { static constexpr bool value = B; };
constexpr int HG_SPLIT = 76;
__device__ __forceinline__ void p5_hg_chunk(Frame& F, bf16* OB) {
    constexpr int PK = 272, PP = 144;
    LAS unsigned char* Qd = F.lds;
    LAS unsigned char* Kinv = Qd + 64 * PK;
    LAS unsigned char* Vv = Kinv + 64 * PK;
    LAS unsigned char* St = Vv + 64 * PP;
    LAS unsigned char* Pm = St + 64 * PK;
    LAS float* totd = (LAS float*)(Pm + 64 * PP);
    LAS float* tot8 = totd + 128;
    LAS float* tot8b = tot8 + 1024;
    LAS float* totdb = tot8b + 1024;
    const bf16* QFI = (const bf16*)(F.ws + WS_R1);
    bf16* JUNK = (bf16*)(F.ws + WS_AB);
    const int tid = F.tid, lane = F.lane, w = F.wave, fr = lane & 15, fq = lane >> 4;
    const int dp = lane, rg = w;
    const int vr = tid >> 3, vs = (tid & 7) * 8;
    const int it = w >> 1, half = w & 1;
    for (int item = blockIdx.x; item < 256; item += F.G) {
        const int part = item >> 7, base = item & 127;
        const int xcd = base & 7, idx = base >> 3, chain = xcd * 8 + (idx >> 1), sl = idx & 1;
        const int b = chain >> 4, h = (chain >> 1) & 7, dir = chain & 1;
        f32x4 Sacc[4];
#pragma unroll
        for (int ct = 0; ct < 4; ++ct) Sacc[ct] = (f32x4){0.f, 0.f, 0.f, 0.f};
        __syncthreads();
        for (int i = tid; i < 64 * PK / 4; i += NT) ((LAS unsigned*)St)[i] = 0u;
        unsigned qA[8], fA[8], qB[8], fB[8]; v4u vA, vB;
#define HG_LOAD(ci) do { \
            const int seg_ = (ci) < 4 ? 0 : 1, cs_ = seg_ == 0 ? (ci) : (ci) - 4, nch_ = seg_ == 0 ? 4 : 128, lo_ = (dir == 0 ? cs_ : nch_ - 1 - cs_) * 64 + seg_ * 256; \
            const bf16* cb_ = QFI + ((size_t)(b * 8 + h) * 8448 + lo_) * 512;     \
            _Pragma("unroll") for (int il = 0; il < 8; ++il) { const int i_ = rg * 8 + il; const bf16* rp_ = cb_ + (dir == 0 ? i_ : 63 - i_) * 512 + 2 * dp; \
                qraw[il] = *(const unsigned*)rp_; fraw[il] = *(const unsigned*)(rp_ + 128 + dir * 128); } \
            vraw = *(const v4u*)(cb_ + (dir == 0 ? vr : 63 - vr) * 512 + 384 + sl * 64 + vs); } while (0)
        auto chunk = [&](auto tag, const int ci, unsigned (&qraw)[8], unsigned (&fraw)[8], v4u& vraw) __attribute__((always_inline)) {
            constexpr bool FULL = decltype(tag)::value;
            const int seg = ci < 4 ? 0 : 1, cs = seg == 0 ? ci : ci - 4, nch = seg == 0 ? 4 : 128, lo = (dir == 0 ? cs : nch - 1 - cs) * 64;
            float f0[8], f1[8], p0[8], p1[8]; float r0 = 1.f, r1 = 1.f;
#pragma unroll
            for (int il = 0; il < 8; ++il) { f0[il] = __builtin_amdgcn_exp2f(bflo(fraw[il])); f1[il] = __builtin_amdgcn_exp2f(bfhi(fraw[il])); r0 *= f0[il]; r1 *= f1[il]; p0[il] = r0; p1[il] = r1; }
            *(LAS f32x2v*)(tot8 + rg * 128 + 2 * dp) = F2V(r0, r1);
            *(LAS v4u*)(Vv + vr * PP + vs * 2) = vraw;
            LDS_BARRIER();
            {
                float o0 = 1.f, o1 = 1.f, a0 = 1.f, a1 = 1.f;
#pragma unroll
                for (int g = 0; g < 8; ++g) { const f32x2v t = *(const LAS f32x2v*)(tot8 + g * 128 + 2 * dp); if (g < rg) { o0 *= t.x; o1 *= t.y; } a0 *= t.x; a1 *= t.y; }
                if (rg == 0) *(LAS f32x2v*)(totd + 2 * dp) = F2V(a0, a1);
                float n0 = __builtin_amdgcn_rcpf(p0[7] * o0), n1 = __builtin_amdgcn_rcpf(p1[7] * o1);
#pragma unroll
                for (int il = 7; il >= 0; --il) {
                    const float e0 = p0[il] * o0, e1 = p1[il] * o1;
                    const int o = (rg * 8 + il) * PK + dp * 4;
                    if constexpr (FULL) *(LAS unsigned*)(Qd + o) = pk2(bflo(qraw[il]) * e0, bfhi(qraw[il]) * e1);
                    *(LAS unsigned*)(Kinv + o) = pk2((1.f - f0[il]) * n0, (1.f - f1[il]) * n1);
                    n0 *= f0[il]; n1 *= f1[il];
                }
            }
            LDS_BARRIER();
            HG_LOAD(ci + 2 < 132 ? ci + 2 : 131);
            f32x4 acc_o[2];
            if constexpr (FULL) {
                bf16x8 aq[4], bs[2][4], bk[2][4];
#pragma unroll
                for (int ks = 0; ks < 4; ++ks) aq[ks] = ld_row(Qd, PK, it * 16, ks * 32, lane);
#pragma unroll
                for (int cc = 0; cc < 2; ++cc)
#pragma unroll
                    for (int ks = 0; ks < 4; ++ks) bs[cc][ks] = ld_row(St, PK, (2 * half + cc) * 16, ks * 32, lane);
                __builtin_amdgcn_sched_barrier(0);
#pragma unroll
                for (int jj = 0; jj < 2; ++jj)
#pragma unroll
                    for (int ks = 0; ks < 4; ++ks) bk[jj][ks] = ld_row(Kinv, PK, (2 * half + jj) * 16, ks * 32, lane);
#pragma unroll
                for (int cc = 0; cc < 2; ++cc) { acc_o[cc] = (f32x4){0.f, 0.f, 0.f, 0.f};
#pragma unroll
                    for (int ks = 0; ks < 4; ++ks) acc_o[cc] = MFMA16(aq[ks], bs[cc][ks], acc_o[cc]); }
                __builtin_amdgcn_sched_barrier(0);
#pragma unroll
                for (int jj = 0; jj < 2; ++jj) {
                    const int jt = 2 * half + jj;
                    f32x4 acc_s = (f32x4){0.f, 0.f, 0.f, 0.f};
                    if (jt <= it) {
#pragma unroll
                        for (int ks = 0; ks < 4; ++ks) acc_s = MFMA16(aq[ks], bk[jj][ks], acc_s);
                    }
#pragma unroll
                    for (int r = 0; r < 4; ++r) {
                        float v = acc_s[r];
                        if (jt == it && (4 * fq + r) < fr) v = 0.f;
                        *(LAS unsigned short*)(Pm + (it * 16 + 4 * fq + r) * PP + (jt * 16 + fr) * 2) = (unsigned short)f2bf(v);
                    }
                }
                LDS_BARRIER();
            }
            {
                const int nks = it >= 2 ? 2 : 1, d0 = 16 * w;
                bf16x8 ap[2], bv[2][2], ak[2], vv[4][2]; float td[4];
                if constexpr (FULL) {
                    ap[0] = ld_row(Pm, PP, it * 16, 0, lane); ap[1] = ld_row(Pm, PP, it * 16, 32, lane);
#pragma unroll
                    for (int cc = 0; cc < 2; ++cc)
#pragma unroll
                        for (int ks = 0; ks < 2; ++ks) bv[cc][ks] = ld_tr(Vv, PP, ks * 32, (2 * half + cc) * 16, lane);
                }
                ak[0] = ld_tr(Kinv, PK, 0, d0, lane); ak[1] = ld_tr(Kinv, PK, 32, d0, lane);
#pragma unroll
                for (int ct = 0; ct < 4; ++ct)
#pragma unroll
                    for (int ks = 0; ks < 2; ++ks) vv[ct][ks] = ld_tr(Vv, PP, ks * 32, ct * 16, lane);
#pragma unroll
                for (int r = 0; r < 4; ++r) td[r] = totd[d0 + 4 * fq + r];
                __builtin_amdgcn_sched_barrier(0);
                if constexpr (FULL) {
#pragma unroll
                for (int cc = 0; cc < 2; ++cc) {
#pragma unroll
                    for (int ks = 0; ks < 2; ++ks) if (ks < nks) acc_o[cc] = MFMA16(ap[ks], bv[cc][ks], acc_o[cc]);
                }
                {
#pragma unroll
                    for (int r = 0; r < 4; ++r) { const int i = it * 16 + 4 * fq + r, p = dir == 0 ? lo + i : lo + 63 - i;
                        bf16* op = seg == 1 ? OB + ((((size_t)dir * 4 + b) * 8 + h) * SEQ + p) * 128 + sl * 64 + 32 * half + fr
                                            : JUNK + ((blockIdx.x & 127) * NT + tid) * 32 + r;
                        op[0] = (bf16)f2bf(acc_o[0][r]); op[16] = (bf16)f2bf(acc_o[1][r]); }
                }
                }
#pragma unroll
                for (int ct = 0; ct < 4; ++ct) {
                    f32x4 acc = Sacc[ct];
#pragma unroll
                    for (int ks = 0; ks < 2; ++ks) acc = MFMA16(ak[ks], vv[ct][ks], acc);
#pragma unroll
                    for (int r = 0; r < 4; ++r) Sacc[ct][r] = acc[r] * td[r];
                    *(LAS v2u*)(St + (ct * 16 + fr) * PK + (d0 + 4 * fq) * 2) = (v2u){pk2(Sacc[ct][0], Sacc[ct][1]), pk2(Sacc[ct][2], Sacc[ct][3])};
                }
            }
            LDS_BARRIER();
        };
        auto state2 = [&](const int ci, unsigned (&q1)[8], unsigned (&f1r)[8], v4u& v1, unsigned (&q2)[8], unsigned (&f2r)[8], v4u& v2) __attribute__((always_inline)) {
            LAS unsigned char* KinvB = Qd; LAS unsigned char* VvB = Pm;
            float fa0[8], fa1[8], fb0[8], fb1[8], ea0, ea1, eb0, eb1;
            {
                float r0 = 1.f, r1 = 1.f;
#pragma unroll
                for (int il = 0; il < 8; ++il) { fa0[il] = __builtin_amdgcn_exp2f(bflo(f1r[il])); fa1[il] = __builtin_amdgcn_exp2f(bfhi(f1r[il])); r0 *= fa0[il]; r1 *= fa1[il]; }
                ea0 = r0; ea1 = r1;
                *(LAS f32x2v*)(tot8 + rg * 128 + 2 * dp) = F2V(r0, r1);
                *(LAS v4u*)(Vv + vr * PP + vs * 2) = v1;
                r0 = 1.f; r1 = 1.f;
#pragma unroll
                for (int il = 0; il < 8; ++il) { fb0[il] = __builtin_amdgcn_exp2f(bflo(f2r[il])); fb1[il] = __builtin_amdgcn_exp2f(bfhi(f2r[il])); r0 *= fb0[il]; r1 *= fb1[il]; }
                eb0 = r0; eb1 = r1;
                *(LAS f32x2v*)(tot8b + rg * 128 + 2 * dp) = F2V(r0, r1);
                *(LAS v4u*)(VvB + vr * PP + vs * 2) = v2;
            }
            LDS_BARRIER();
#define HG_KINV(T8, TD, KI, F0, F1, E0, E1) do { float o0 = 1.f, o1 = 1.f, a0 = 1.f, a1 = 1.f; \
                _Pragma("unroll") for (int g = 0; g < 8; ++g) { const f32x2v t = *(const LAS f32x2v*)(T8 + g * 128 + 2 * dp); if (g < rg) { o0 *= t.x; o1 *= t.y; } a0 *= t.x; a1 *= t.y; } \
                if (rg == 0) *(LAS f32x2v*)(TD + 2 * dp) = F2V(a0, a1); \
                float n0 = __builtin_amdgcn_rcpf(E0 * o0), n1 = __builtin_amdgcn_rcpf(E1 * o1); \
                _Pragma("unroll") for (int il = 7; il >= 0; --il) { *(LAS unsigned*)(KI + (rg * 8 + il) * PK + dp * 4) = pk2((1.f - F0[il]) * n0, (1.f - F1[il]) * n1); n0 *= F0[il]; n1 *= F1[il]; } } while (0)
            HG_KINV(tot8, totd, Kinv, fa0, fa1, ea0, ea1);
            HG_KINV(tot8b, totdb, KinvB, fb0, fb1, eb0, eb1);
#undef HG_KINV
            LDS_BARRIER();
            { const int c1 = ci + 4 < 132 ? ci + 4 : 131, c2 = ci + 5 < 132 ? ci + 5 : 131;
              { unsigned (&qraw)[8] = q1; unsigned (&fraw)[8] = f1r; v4u& vraw = v1; HG_LOAD(c1); }
              { unsigned (&qraw)[8] = q2; unsigned (&fraw)[8] = f2r; v4u& vraw = v2; HG_LOAD(c2); } }
            {
                const int d0 = 16 * w;
                bf16x8 ak[2], vv[4][2]; float td[4];
#pragma unroll
                for (int cc = 0; cc < 2; ++cc) {
                    LAS unsigned char* KI = cc == 0 ? Kinv : KinvB; LAS unsigned char* VI = cc == 0 ? Vv : VvB; LAS float* TD = cc == 0 ? totd : totdb;
                    ak[0] = ld_tr(KI, PK, 0, d0, lane); ak[1] = ld_tr(KI, PK, 32, d0, lane);
#pragma unroll
                    for (int ct = 0; ct < 4; ++ct)
#pragma unroll
                        for (int ks = 0; ks < 2; ++ks) vv[ct][ks] = ld_tr(VI, PP, ks * 32, ct * 16, lane);
#pragma unroll
                    for (int r = 0; r < 4; ++r) td[r] = TD[d0 + 4 * fq + r];
                    __builtin_amdgcn_sched_barrier(0);
#pragma unroll
                    for (int ct = 0; ct < 4; ++ct) {
                        f32x4 acc = Sacc[ct];
#pragma unroll
                        for (int ks = 0; ks < 2; ++ks) acc = MFMA16(ak[ks], vv[ct][ks], acc);
#pragma unroll
                        for (int r = 0; r < 4; ++r) Sacc[ct][r] = acc[r] * td[r];
                        if (cc == 1) *(LAS v2u*)(St + (ct * 16 + fr) * PK + (d0 + 4 * fq) * 2) = (v2u){pk2(Sacc[ct][0], Sacc[ct][1]), pk2(Sacc[ct][2], Sacc[ct][3])};
                    }
                    __builtin_amdgcn_sched_barrier(0);
                }
            }
            LDS_BARRIER();
        };
        { unsigned (&qraw)[8] = qA; unsigned (&fraw)[8] = fA; v4u& vraw = vA; HG_LOAD(0); }
        { unsigned (&qraw)[8] = qB; unsigned (&fraw)[8] = fB; v4u& vraw = vB; HG_LOAD(1); }
        if (part == 0) {
            for (int ci = 0; ci < HG_SPLIT; ci += 2) { chunk(HgTag<true>{}, ci, qA, fA, vA); chunk(HgTag<true>{}, ci + 1, qB, fB, vB); }
        } else {
            unsigned qC[8], fC[8], qD[8], fD[8]; v4u vC, vD;
            { unsigned (&qraw)[8] = qC; unsigned (&fraw)[8] = fC; v4u& vraw = vC; HG_LOAD(2); }
            { unsigned (&qraw)[8] = qD; unsigned (&fraw)[8] = fD; v4u& vraw = vD; HG_LOAD(3); }
            for (int ci = 0; ci < HG_SPLIT; ci += 4) { state2(ci, qA, fA, vA, qB, fB, vB); state2(ci + 2, qC, fC, vC, qD, fD, vD); }
            for (int ci = HG_SPLIT; ci < 132; ci += 2) { chunk(HgTag<true>{}, ci, qA, fA, vA); chunk(HgTag<true>{}, ci + 1, qB, fB, vB); }
        }
#undef HG_LOAD
    }
}
typedef unsigned v6u __attribute__((ext_vector_type(6)));
typedef unsigned v3u __attribute__((ext_vector_type(3)));
typedef v3u v3u_a4 __attribute__((aligned(4)));
typedef v4u v4u_a8 __attribute__((aligned(8)));
typedef float v32f __attribute__((ext_vector_type(32)));
typedef __bf16 v32bf __attribute__((ext_vector_type(32)));
__device__ __forceinline__ void side_work(Frame& F, int sid, int nside) {
    const float* w_in = late_arg(7); const float* w_pa = late_arg(14); const float* w_pb = late_arg(15); const float* w_o = late_arg(16); const float* w_query = late_arg(18);
    const float* sub_keys = late_arg(19); const float* expert_u = late_arg(20); const float* expert_v = late_arg(21);
    const int gw = sid * NWAVES + F.wave, NGW = nside * NWAVES;
    {
        LAS float* scr = (LAS float*)(F.lds + 49152 + F.wave * 8448);
        bf16* WTC = (bf16*)(F.ws + WS_WTC);
        constexpr int J3 = 16 * 32, J4 = 16 * 32, J5 = 16 * 64, J6 = 16 * 32, J7 = 16 * 32, J8 = 16 * 32, J9 = 16 * 64;
        for (int it = gw; it < J3 + J4 + J5 + J6 + J7 + J8 + J9; it += NGW) {
            int r = it;
        if (r < J3) { p0_transpose_item(w_in + C_GA, NIN, 1024, D, WTC, scr, r, F.lane); continue; } r -= J3;
        if (r < J4) { p0_transpose_item(w_in + C_GB, NIN, 1024, D, WTC + (size_t)1024 * D, scr, r, F.lane); continue; } r -= J4;
        if (r < J5) { p0_transpose_item(w_in + C_MG, NIN, 2048, D, WTC + (size_t)2048 * D, scr, r, F.lane); continue; } r -= J5;
        if (r < J6) { p0_transpose_item(w_pa, 1024, 1024, D, (bf16*)(F.ws + WS_WTPA), scr, r, F.lane, 2048); continue; } r -= J6;
        if (r < J7) { p0_transpose_item(w_pb, 1024, 1024, D, (bf16*)(F.ws + WS_WTPA) + 1024, scr, r, F.lane, 2048); continue; } r -= J7;
        if (r < J8) { p0_transpose_item(w_o, 1024, 1024, D, (bf16*)(F.ws + WS_WTO), scr, r, F.lane); continue; } r -= J8;
        p0_transpose_item(w_query, 2048, 2048, D, (bf16*)(F.ws + WS_WTQ), scr, r, F.lane);
        }
    }
    { const f32x4* sk = (const f32x4*)sub_keys; v2u* o = (v2u*)(F.ws + WS_SKB);
      for (int i = sid * NT + F.tid; i < 65536; i += nside * NT) { const f32x4 v = sk[i]; o[i] = (v2u){pk2(v.x, v.y), pk2(v.z, v.w)}; } }
    for (int row0 = 2 * gw; row0 < 2 * 16384; row0 += 2 * NGW) {
        f32x4 v[2][4]; float am[2];
#pragma unroll
        for (int k = 0; k < 2; ++k) { const int row = row0 + k, tb = row >> 14, r = row & 16383;
            const f32x4* sp = (const f32x4*)((tb == 0 ? expert_u : expert_v) + (size_t)r * D + 16 * F.lane);
#pragma unroll
            for (int q = 0; q < 4; ++q) v[k][q] = sp[q]; }
#pragma unroll
        for (int k = 0; k < 2; ++k) { float a = 0.f;
#pragma unroll
            for (int q = 0; q < 4; ++q) a = fmaxf(a, fmaxf(fmaxf(fabsf(v[k][q].x), fabsf(v[k][q].y)), fmaxf(fabsf(v[k][q].z), fabsf(v[k][q].w))));
            am[k] = a; }
#pragma unroll
        for (int o = 1; o < 64; o <<= 1) { am[0] = fmaxf(am[0], __shfl_xor(am[0], o)); am[1] = fmaxf(am[1], __shfl_xor(am[1], o)); }
#pragma unroll
        for (int k = 0; k < 2; ++k) { const int row = row0 + k, tb = row >> 14, r = row & 16383;
            const float scale = am[k] > 0.f ? am[k] * (1.f / 7.5f) : 1.f, inv = 1.f / scale;
            unsigned c[16];
#pragma unroll
            for (int q = 0; q < 4; ++q) {
#pragma unroll
                for (int i = 0; i < 4; ++i) {
                    const float x = v[k][q][i] * inv, a = fminf(fabsf(x), 7.5f);
                    int e = (int)(__builtin_bit_cast(unsigned, a) >> 23) - 127; e = e < 0 ? 0 : e;
                    const float m8 = __builtin_rintf(a * __builtin_bit_cast(float, (unsigned)(130 - e) << 23));
                    c[4 * q + i] = ((unsigned)(int)m8 + 8u * (unsigned)e) | (x < 0.f ? 32u : 0u); }
            }
            unsigned long long lo = 0ull;
#pragma unroll
            for (int i = 0; i < 10; ++i) lo |= (unsigned long long)c[i] << (6 * i);
            lo |= (unsigned long long)c[10] << 60;
            const unsigned d2 = (c[10] >> 4) | (c[11] << 2) | (c[12] << 8) | (c[13] << 14) | (c[14] << 20) | (c[15] << 26);
            *(v3u_a4*)(F.ws + (tb == 0 ? ws_eux(F.lane >> 3) + (size_t)r * 128 + 32 * ((F.lane & 7) >> 1) + 12 * (F.lane & 1)
                                      : WS_EV6 + (size_t)r * 768 + 12 * F.lane)) = (v3u){(unsigned)lo, (unsigned)(lo >> 32), d2};
            if (F.lane == 0) ((float*)(F.ws + WS_ESC))[row] = scale; }
    }
}

__device__ __forceinline__ void p10_h2(Frame& F) {
    const float* norm2_w = late_arg(17);
    const int gw = blockIdx.x * NWAVES + F.wave, NGW = F.G * NWAVES;
    const float* MOD = (const float*)(F.ws + WS_MOD); const bf16* X1 = (const bf16*)(F.ws + WS_R1); bf16* H2 = (bf16*)(F.ws + WS_H);
    {
        const float* sub_keys = late_arg(19); const bf16* WTQ = (const bf16*)(F.ws + WS_WTQ); bf16* WTF = (bf16*)(F.ws + WS_WTF);
        for (int row = gw; row < 2048; row += NGW) {
            const bf16* wq = WTQ + (size_t)(row >> 7) * 128 * D + 16 * F.lane; const float* sk = sub_keys + (size_t)row * 128;
            float a[16];
#pragma unroll
            for (int j = 0; j < 16; ++j) a[j] = 0.f;
#pragma unroll 4
            for (int d = 0; d < 128; ++d) { const float sv = sk[d]; const v4u w0 = *(const v4u*)(wq + (size_t)d * D), w1 = *(const v4u*)(wq + (size_t)d * D + 8);
#pragma unroll
                for (int e = 0; e < 4; ++e) { a[2 * e] = fmaf(sv, bflo(w0[e]), a[2 * e]); a[2 * e + 1] = fmaf(sv, bfhi(w0[e]), a[2 * e + 1]); a[8 + 2 * e] = fmaf(sv, bflo(w1[e]), a[8 + 2 * e]); a[9 + 2 * e] = fmaf(sv, bfhi(w1[e]), a[9 + 2 * e]); } }
            *(v4u*)(WTF + (size_t)row * D + 16 * F.lane) = (v4u){pk2(a[0], a[1]), pk2(a[2], a[3]), pk2(a[4], a[5]), pk2(a[6], a[7])};
            *(v4u*)(WTF + (size_t)row * D + 16 * F.lane + 8) = (v4u){pk2(a[8], a[9]), pk2(a[10], a[11]), pk2(a[12], a[13]), pk2(a[14], a[15])};
        }
    }
    for (int r0 = 2 * gw; r0 < NLAT; r0 += 2 * NGW) {
        v4u raw[2][2]; float ss[2];
#pragma unroll
        for (int k = 0; k < 2; ++k)
#pragma unroll
            for (int j = 0; j < 2; ++j) raw[k][j] = *(const v4u*)(X1 + (size_t)(r0 + k) * D + 512 * j + 8 * F.lane);
#pragma unroll
        for (int k = 0; k < 2; ++k) { float sq = 0.f;
#pragma unroll
            for (int j = 0; j < 2; ++j)
#pragma unroll
                for (int e = 0; e < 4; ++e) { const float a = bflo(raw[k][j][e]), b = bfhi(raw[k][j][e]); sq += a * a + b * b; }
            ss[k] = sq; }
#pragma unroll
        for (int o = 1; o < 64; o <<= 1) { ss[0] += __shfl_xor(ss[0], o); ss[1] += __shfl_xor(ss[1], o); }
        const float* md = MOD + (size_t)(r0 >> 13) * 6144;
#pragma unroll
        for (int j = 0; j < 2; ++j) { const int c0 = 512 * j + 8 * F.lane;
            const f32x4 w0 = *(const f32x4*)(norm2_w + c0), w1 = *(const f32x4*)(norm2_w + c0 + 4), h0 = *(const f32x4*)(md + 3072 + c0), h1 = *(const f32x4*)(md + 3072 + c0 + 4),
                        s0 = *(const f32x4*)(md + 4096 + c0), s1 = *(const f32x4*)(md + 4096 + c0 + 4);
#pragma unroll
            for (int k = 0; k < 2; ++k) { const float r = rsqrtf(ss[k] * (1.f / D) + EPS);
                const f32x4 x0 = (f32x4){bflo(raw[k][j].x), bfhi(raw[k][j].x), bflo(raw[k][j].y), bfhi(raw[k][j].y)}, x1 = (f32x4){bflo(raw[k][j].z), bfhi(raw[k][j].z), bflo(raw[k][j].w), bfhi(raw[k][j].w)};
                const f32x4 y0 = x0 * r * w0 * (s0 + 1.f) + h0, y1 = x1 * r * w1 * (s1 + 1.f) + h1;
                *(v4u*)(H2 + (size_t)(r0 + k) * D + c0) = (v4u){pk2(y0.x, y0.y), pk2(y0.z, y0.w), pk2(y1.x, y1.y), pk2(y1.z, y1.w)}; } }
    }
}

__device__ __forceinline__ void ins16(unsigned (&top)[16], unsigned x) {
#pragma unroll
    for (int k = 0; k < 16; ++k) { const unsigned hi = top[k] > x ? top[k] : x; x = top[k] > x ? x : top[k]; top[k] = hi; }
}
#define CAS_DESC(a, b) do { const unsigned hi_ = (a) > (b) ? (a) : (b), lo_ = (a) > (b) ? (b) : (a); (a) = hi_; (b) = lo_; } while (0)
__device__ __forceinline__ void bitonic_sort16_desc(unsigned (&v)[16]) {
#pragma unroll
    for (int k = 2; k <= 16; k <<= 1)
#pragma unroll
        for (int j = k >> 1; j > 0; j >>= 1)
#pragma unroll
            for (int i = 0; i < 16; ++i) { const int l = i ^ j; if (l > i) { if ((i & k) == 0) CAS_DESC(v[i], v[l]); else CAS_DESC(v[l], v[i]); } }
}
__device__ __forceinline__ void bitonic_merge16_desc(unsigned (&v)[16]) {
#pragma unroll
    for (int j = 8; j > 0; j >>= 1)
#pragma unroll
        for (int i = 0; i < 16; ++i) { const int l = i ^ j; if (l > i) CAS_DESC(v[i], v[l]); }
}
__device__ __forceinline__ float ord16_to_float(unsigned o) {
    const unsigned hb = (o & 0x8000u) ? (o ^ 0x8000u) : (~o & 0xffffu);
    return (float)__builtin_bit_cast(_Float16, (unsigned short)hb);
}
__device__ __forceinline__ void p12_topk(Frame& F) {
    const unsigned short* SCG = (const unsigned short*)(F.ws + WS_R1 + 128 * MiB);
    int* EIDX = (int*)(F.ws + WS_OB + 64 * MiB); float* EG = (float*)(F.ws + WS_OB + 80 * MiB);
    const int lane = F.lane, h = F.wave, tok = 16 * (lane & 3) + (lane >> 2);
    LAS unsigned char* PAY = (LAS unsigned char*)(F.lds + h * 16384);
    for (int item = blockIdx.x; item < NLAT / 64; item += F.G) {
        const int t0 = item * 64;
        unsigned top[2][16];
#pragma unroll
        for (int c = 0; c < 2; ++c) {
#pragma unroll
            for (int k = 0; k < 16; ++k) top[c][k] = 0u;
            const unsigned short* sp = SCG + ((size_t)(item * 8 + h) * 2 + c) * 8192 + lane;
            unsigned short raw[16], nxt[16];
#pragma unroll
            for (int k = 0; k < 16; ++k) raw[k] = sp[k * 64];
#pragma unroll 1
            for (int g = 0; g < 8; ++g) {
                const int gn = g < 7 ? g + 1 : 7;
#pragma unroll
                for (int k = 0; k < 16; ++k) nxt[k] = sp[(gn * 16 + k) * 64];
                unsigned grp[16];
#pragma unroll
                for (int k = 0; k < 16; ++k) { const int key = g * 16 + k; const unsigned hb = raw[k];
                    const unsigned o = (hb & 0x8000u) ? (~hb & 0xffffu) : (hb | 0x8000u); grp[k] = (o << 16) | (unsigned)(127 - key); }
                bitonic_sort16_desc(grp);
#pragma unroll
                for (int k = 0; k < 16; ++k) top[c][k] = top[c][k] > grp[15 - k] ? top[c][k] : grp[15 - k];
                bitonic_merge16_desc(top[c]);
#pragma unroll
                for (int k = 0; k < 16; ++k) raw[k] = nxt[k];
            }
        }
        float f1[16], f2[16];
#pragma unroll
        for (int k = 0; k < 16; ++k) { f1[k] = ord16_to_float(top[0][k] >> 16); f2[k] = ord16_to_float(top[1][k] >> 16);
            PAY[k * 64 + lane] = (unsigned char)(127u - (top[0][k] & 127u)); PAY[(16 + k) * 64 + lane] = (unsigned char)(127u - (top[1][k] & 127u)); }
        unsigned best[16];
#pragma unroll
        for (int k = 0; k < 16; ++k) best[k] = 0u;
#pragma unroll
        for (int i = 0; i < 16; ++i)
#pragma unroll
            for (int j = 0; j < 16; ++j)
                if ((i + 1) * (j + 1) <= 16) {
                    const unsigned bits = __builtin_bit_cast(unsigned, f1[i] + f2[j]);
                    const unsigned u = bits ^ ((bits & 0x80000000u) ? 0xffffffffu : 0x80000000u);
                    ins16(best, (u & 0xffffff00u) | (unsigned)(255 - (i * 16 + j)));
                }
        float val[16], esum = 0.f;
#pragma unroll
        for (int k = 0; k < 16; ++k) { const unsigned u = best[k] & 0xffffff00u; val[k] = __builtin_bit_cast(float, (u & 0x80000000u) ? (u ^ 0x80000000u) : ~u); }
        const float vmax = val[0];
#pragma unroll
        for (int k = 0; k < 16; ++k) { val[k] = __expf(val[k] - vmax); esum += val[k]; }
        const float rs = 1.f / esum;
        asm volatile("s_waitcnt lgkmcnt(0)" ::: "memory");
        int eidx[16];
#pragma unroll
        for (int k = 0; k < 16; ++k) { const unsigned flat = 255u - (best[k] & 255u); const unsigned i = flat >> 4, j = flat & 15u;
            eidx[k] = (int)PAY[i * 64 + lane] * 128 + (int)PAY[(16 + j) * 64 + lane]; }
        const size_t ob = ((size_t)(t0 + tok) * 8 + h) * 16;
        const float* ESC = (const float*)(F.ws + WS_ESC);
        float* EUS = (float*)(F.ws + WS_OB + 96 * MiB);
#pragma unroll
        for (int q = 0; q < 4; ++q) {
            *(v4u*)(EIDX + ob + 4 * q) = (v4u){(unsigned)eidx[4 * q], (unsigned)eidx[4 * q + 1], (unsigned)eidx[4 * q + 2], (unsigned)eidx[4 * q + 3]};
            *(f32x4*)(EG + ob + 4 * q) = (f32x4){val[4 * q] * rs * ESC[16384 + eidx[4 * q]], val[4 * q + 1] * rs * ESC[16384 + eidx[4 * q + 1]], val[4 * q + 2] * rs * ESC[16384 + eidx[4 * q + 2]], val[4 * q + 3] * rs * ESC[16384 + eidx[4 * q + 3]]};
            *(f32x4*)(EUS + ob + 4 * q) = (f32x4){ESC[eidx[4 * q]], ESC[eidx[4 * q + 1]], ESC[eidx[4 * q + 2]], ESC[eidx[4 * q + 3]]};
        }
    }
}

typedef __bf16 bf2_t __attribute__((ext_vector_type(2)));
__device__ __forceinline__ float dot2bf(unsigned a, unsigned b, float c) { return __builtin_amdgcn_fdot2_f32_bf16(__builtin_bit_cast(bf2_t, a), __builtin_bit_cast(bf2_t, b), c, false); }
template <int CTRL, int RMASK> __device__ __forceinline__ float dpp_get(float x) { return __builtin_bit_cast(float, __builtin_amdgcn_update_dpp(0, __builtin_bit_cast(int, x), CTRL, RMASK, 0xF, false)); }
__device__ __forceinline__ float wave_sum_uniform(float s) {
    s += dpp_get<0xB1, 0xF>(s); s += dpp_get<0x4E, 0xF>(s); s += dpp_get<0x124, 0xF>(s); s += dpp_get<0x128, 0xF>(s);
    s += dpp_get<0x142, 0xA>(s); s += dpp_get<0x143, 0xC>(s);
    return __builtin_bit_cast(float, __builtin_amdgcn_readlane(__builtin_bit_cast(int, s), 63));
}
__device__ __forceinline__ float gelu_erf(float v) {
    const float av = fabsf(v), t = __builtin_amdgcn_rcpf(fmaf(av, 0.2316418882f, 1.0f));
    float q = fmaf(t, 0.5307027145f, -0.7265760135f); q = fmaf(q, t, 0.7107068705f); q = fmaf(q, t, -0.142248368f); q = fmaf(q, t, 0.127414796f); q = q * t;
    const float e = __builtin_amdgcn_exp2f(v * v * -0.72134752044f);
    const float m = v * (q * e);
    return v < 0.f ? m : v - m;
}
__device__ __forceinline__ float half_sum_sel(float s, int hf) {
    s += dpp_get<0xB1, 0xF>(s); s += dpp_get<0x4E, 0xF>(s); s += dpp_get<0x124, 0xF>(s); s += dpp_get<0x128, 0xF>(s);
    s += dpp_get<0x142, 0xA>(s);
    const int lo = __builtin_amdgcn_readlane(__builtin_bit_cast(int, s), 31), hi = __builtin_amdgcn_readlane(__builtin_bit_cast(int, s), 63);
    return __builtin_bit_cast(float, hf ? hi : lo);
}
__device__ __forceinline__ v6u ld6(const unsigned char* p) { const v4u a = *(const v4u_a8*)p; const v2u b = *(const v2u*)(p + 16); return (v6u){a.x, a.y, a.z, a.w, b.x, b.y}; }
__device__ __forceinline__ void p13a_peer_u(Frame& F) {
    const int lane = F.lane, tg = lane >> 2, un = lane & 3;
    const bf16* H2 = (const bf16*)(F.ws + WS_H);
    const int* EIDX = (const int*)(F.ws + WS_OB + 64 * MiB);
    float* PD = (float*)(F.ws + WS_R1 + 128 * MiB);
    const int classes = F.G < 8 ? F.G : 8, cls = (int)blockIdx.x % classes, nwg = (F.G - cls + classes - 1) / classes;
    const int ws = ((int)blockIdx.x / classes) * NWAVES + F.wave, nws = nwg * NWAVES;
    for (int x = cls; x < 8; x += classes) {
        const unsigned char* UX = F.ws + ws_eux(x) + 32 * un;
        for (int grp = ws; grp < NLAT / 16; grp += nws) {
            const int t = grp * 16 + tg;
            unsigned hp[16];
#pragma unroll
            for (int q = 0; q < 4; ++q) { const v4u a = *(const v4u*)(H2 + (size_t)t * D + 128 * x + 32 * un + 8 * q); hp[4 * q] = a.x; hp[4 * q + 1] = a.y; hp[4 * q + 2] = a.z; hp[4 * q + 3] = a.w; }
            const v4u* ep = (const v4u*)(EIDX + (size_t)t * NPEER);
            float* pd = PD + ((size_t)x * NLAT + t) * NPEER;
            v6u U0[4], U1[4], U2[4], U3[4];
#define PU_LOAD(U, e_) do { _Pragma("unroll") for (int j_ = 0; j_ < 4; ++j_) U[j_] = ld6(UX + (size_t)(e_)[j_] * 128); } while (0)
#define PU_COMP(U, s4) do { f32x4 dq_; _Pragma("unroll") for (int j_ = 0; j_ < 4; ++j_) { const v32bf ub_ = __builtin_amdgcn_cvt_scalef32_pk32_bf16_fp6(U[j_], 1.0f); float d_ = 0.f; \
                _Pragma("unroll") for (int i_ = 0; i_ < 16; ++i_) { const bf2_t a_ = {ub_[2 * i_], ub_[2 * i_ + 1]}; d_ = __builtin_amdgcn_fdot2_f32_bf16(a_, __builtin_bit_cast(bf2_t, hp[i_]), d_, false); } \
                d_ += dpp_get<0xB1, 0xF>(d_); d_ += dpp_get<0x4E, 0xF>(d_); dq_[j_] = d_; } \
            if (un == 0) *(f32x4*)(pd + 4 * (s4)) = dq_; } while (0)
            v4u e3 = ep[3];
            { const v4u e0 = ep[0], e1 = ep[1], e2 = ep[2]; PU_LOAD(U0, e0); PU_LOAD(U1, e1); PU_LOAD(U2, e2); }
            for (int s4 = 0; s4 < 32; s4 += 4) {
                const int nb = s4 + 4 < 32 ? s4 + 4 : 28;
                const v4u n0 = ep[nb], n1 = ep[nb + 1], n2 = ep[nb + 2], n3 = ep[nb + 3];
                PU_LOAD(U3, e3); PU_COMP(U0, s4);
                PU_LOAD(U0, n0); PU_COMP(U1, s4 + 1);
                PU_LOAD(U1, n1); PU_COMP(U2, s4 + 2);
                PU_LOAD(U2, n2); PU_COMP(U3, s4 + 3);
                e3 = n3;
            }
#undef PU_LOAD
#undef PU_COMP
        }
    }
}
__device__ __forceinline__ void p13_peer(Frame& F) {
    const float* final_norm_w = late_arg(22);
    const int gw = blockIdx.x * NWAVES + F.wave, NGW = F.G * NWAVES, lane = F.lane, hf = lane >> 5, li = lane & 31;
    const float* MOD = (const float*)(F.ws + WS_MOD); const bf16* X1 = (const bf16*)(F.ws + WS_R1);
    const unsigned char* EV6 = F.ws + WS_EV6;
    const int* EIDX = (const int*)(F.ws + WS_OB + 64 * MiB); const float* EG = (const float*)(F.ws + WS_OB + 80 * MiB); const float* EUS = (const float*)(F.ws + WS_OB + 96 * MiB);
    const float* PD = (const float*)(F.ws + WS_R1 + 128 * MiB);
    int eN0 = 0, eN1 = 0; float pN0[8], pN1[8], uN0 = 0.f, uN1 = 0.f, gN0 = 0.f, gN1 = 0.f;
#define PEER_TOK(tt) do { eN0 = EIDX[(size_t)(tt) * NPEER + lane]; eN1 = EIDX[(size_t)(tt) * NPEER + 64 + lane]; \
        uN0 = EUS[(size_t)(tt) * NPEER + lane]; uN1 = EUS[(size_t)(tt) * NPEER + 64 + lane]; gN0 = EG[(size_t)(tt) * NPEER + lane]; gN1 = EG[(size_t)(tt) * NPEER + 64 + lane]; \
        _Pragma("unroll") for (int x_ = 0; x_ < 8; ++x_) { pN0[x_] = PD[((size_t)x_ * NLAT + (tt)) * NPEER + lane]; pN1[x_] = PD[((size_t)x_ * NLAT + (tt)) * NPEER + 64 + lane]; } } while (0)
    if (gw < NLAT) PEER_TOK(gw);
    for (int t = gw; t < NLAT; t += NGW) {
        float y[32];
#pragma unroll
        for (int i = 0; i < 32; ++i) y[i] = 0.f;
        const int ei0 = eN0, ei1 = eN1;
        float d0 = 0.f, d1 = 0.f;
#pragma unroll
        for (int x_ = 0; x_ < 8; ++x_) { d0 += pN0[x_]; d1 += pN1[x_]; }
        const int ac0 = __builtin_bit_cast(int, gelu_erf(d0 * uN0) * gN0), ac1 = __builtin_bit_cast(int, gelu_erf(d1 * uN1) * gN1);
        { const int tn = t + NGW < NLAT ? t + NGW : t; PEER_TOK(tn); }
        constexpr int NPB = 4;
        v6u V0[NPB], V1[NPB]; int A0[NPB], A1[NPB];
#define PEER_LOAD(V, A, bt) do { const bool lo_ = (bt) < 32 / NPB; const int se_ = lo_ ? ei0 : ei1, sa_ = lo_ ? ac0 : ac1; \
            _Pragma("unroll") for (int p_ = 0; p_ < NPB; ++p_) { const int sl_ = ((((bt) * 2 * NPB + 2 * p_) & 63) + hf) << 2; \
                const unsigned off_ = (unsigned)__builtin_amdgcn_ds_bpermute(sl_, se_) * 768u + 24u * (unsigned)li; \
                V[p_] = ld6(EV6 + off_); A[p_] = __builtin_amdgcn_ds_bpermute(sl_, sa_); } } while (0)
#define PEER_COMP(V, A) do { \
            _Pragma("unroll") for (int p_ = 0; p_ < NPB; ++p_) { const float act_ = __builtin_bit_cast(float, A[p_]); \
                const v32f vv_ = __builtin_amdgcn_cvt_scalef32_pk32_f32_fp6(V[p_], 1.0f); \
                _Pragma("unroll") for (int j_ = 0; j_ < 32; ++j_) y[j_] = fmaf(act_, vv_[j_], y[j_]); } } while (0)
        PEER_LOAD(V0, A0, 0);
        for (int bt = 0; bt < 64 / NPB; bt += 2) {
            PEER_LOAD(V1, A1, bt + 1);
            PEER_COMP(V0, A0);
            PEER_LOAD(V0, A0, bt + 2 < 64 / NPB ? bt + 2 : 64 / NPB - 1);
            PEER_COMP(V1, A1);
        }
#undef PEER_LOAD
#undef PEER_COMP
        float yy[16];
#pragma unroll
        for (int i = 0; i < 16; ++i) { const float a = y[i] + __shfl_xor(y[i], 32), b = y[16 + i] + __shfl_xor(y[16 + i], 32); yy[i] = hf ? b : a; }
        const float* g2 = MOD + (size_t)(t >> 13) * 6144 + 5120;
        const int ch0 = 32 * li + 16 * hf;
        float x2[16]; float ss = 0.f;
        const v4u xa = *(const v4u*)(X1 + (size_t)t * D + ch0), xb = *(const v4u*)(X1 + (size_t)t * D + ch0 + 8);
#pragma unroll
        for (int q = 0; q < 4; ++q) { const int col = ch0 + 4 * q;
            const unsigned w0 = q < 2 ? xa[2 * q] : xb[2 * q - 4], w1 = q < 2 ? xa[2 * q + 1] : xb[2 * q - 3];
            const f32x4 xv = (f32x4){bflo(w0), bfhi(w0), bflo(w1), bfhi(w1)}, gv = *(const f32x4*)(g2 + col);
#pragma unroll
            for (int i = 0; i < 4; ++i) { const float v = xv[i] + gv[i] * yy[q * 4 + i]; x2[q * 4 + i] = v; ss += v * v; } }
        const float r = rsqrtf(wave_sum(ss) * (1.f / D) + EPS);
#pragma unroll
        for (int q = 0; q < 4; ++q) { const int col = ch0 + 4 * q; const f32x4 wv = *(const f32x4*)(final_norm_w + col); f32x4 o;
#pragma unroll
            for (int i = 0; i < 4; ++i) o[i] = x2[q * 4 + i] * r * wv[i];
            *(f32x4*)(F.out + (size_t)t * D + col) = o; }
    }
}
#undef PEER_TOK
struct Args { const float* in[23]; float* out; unsigned char* ws; };
__global__ void __launch_bounds__(NT, 2) fwd_megakernel(Args args) {
    extern __shared__ __attribute__((aligned(16))) unsigned char lds[];
    Frame F;
    F.lds = (LAS unsigned char*)lds;
    F.tid = threadIdx.x; F.lane = F.tid & 63; F.wave = __builtin_amdgcn_readfirstlane(F.tid >> 6); F.G = gridDim.x;
    F.x = args.in[0]; F.c = args.in[1]; F.ctx = args.in[2]; F.c_ctx = args.in[3]; F.w_ada = args.in[4]; F.b_ada = args.in[5]; F.norm1_w = args.in[6]; F.w_in = args.in[7];
    F.lb_logits = args.in[12]; F.w_pa = args.in[14];
    F.w_pb = args.in[15]; F.w_o = args.in[16]; F.w_query = args.in[18]; F.sub_keys = args.in[19];
    F.out = args.out; F.ws = args.ws;
    volatile LAS unsigned* MISC = (volatile LAS unsigned*)(F.lds + MISC_OFF);
    if (F.tid < 64) MISC[F.tid] = 0u;
    __syncthreads();
    XcdBarrier bar = xcd_barrier_post((unsigned*)(F.ws + WS_CTL) + CW_BAR, MISC + 8);
#define GRID_BAR() xcd_barrier(bar)
    unsigned char* ws = F.ws;
    bf16* OA = (bf16*)F.out;
    bf16* OB = (bf16*)(ws + WS_OB);

#ifndef PROBE_MASK
#define PROBE_MASK 0
#endif
#define PHASE_IDS() do { asm volatile("" : "+v"(F.tid)); F.lane = F.tid & 63; { GAS unsigned char* wg_ = (GAS unsigned char*)F.ws; GAS float* og_ = (GAS float*)F.out; asm volatile("" : "+s"(wg_), "+s"(og_)); F.ws = (unsigned char*)wg_; F.out = (float*)og_; } ws = F.ws; OA = (bf16*)F.out; OB = (bf16*)(ws + WS_OB); } while (0)
#define PH(k, ...) do { PHASE_IDS(); __VA_ARGS__; if ((PROBE_MASK >> (k)) & 1) { GRID_BAR(); __VA_ARGS__; } } while (0)
    PH(0, p0_prologue(F));
    GRID_BAR();
    PH(1, p1_h(F));
    GRID_BAR();
    PH(2, {
        pg8::Gemm g{(const pg8::bf16_t*)(ws + WS_H), (const pg8::bf16_t*)(ws + WS_WTA), NROW, NA, D}; pg8::StaticOrder S; S.init(NROW, NA, F.G, (int)blockIdx.x);
        pg8::EpiA E{(pg8::bf16_t*)(ws + WS_R1), (float*)(ws + WS_AB), late_arg(9), late_arg(10)};
        pg8::gemm_phase<pg8::EpiA, pg8::StaticOrder, true, true>(F.lds, g, S, E);
    });
    GRID_BAR();
    PH(3, p2b_gdn_prep(F));
    GRID_BAR();
    PH(15, p3a_gdn_tw(F));
    GRID_BAR();
    PH(4, p3_gdn_chunk(F, OA));
    GRID_BAR();
    PH(5, {
        pg8::Gemm g{(const pg8::bf16_t*)(ws + WS_H), (const pg8::bf16_t*)(ws + WS_WTB), NROW, 4096, D}; pg8::StaticOrder S; S.init(NROW, 4096, F.G, (int)blockIdx.x);
        pg8::EpiB E{(pg8::bf16_t*)(ws + WS_R1), (const float*)(ws + WS_LB)};
        pg8::gemm_phase<pg8::EpiB, pg8::StaticOrder, true, true>(F.lds, g, S, E);
    });
    GRID_BAR();
    PH(6, { p5_hg_chunk(F, OB); if (F.G < 256) side_work(F, (int)blockIdx.x, F.G); else if ((int)blockIdx.x < 128) side_work(F, (int)blockIdx.x, 128); });
    GRID_BAR();
    PHASE_IDS();
    {
        pg8::Gemm g{(const pg8::bf16_t*)(ws + WS_H) + (size_t)NCTX * D, (const pg8::bf16_t*)(ws + WS_WTC), NLAT, 4096, D}; pg8::StaticOrder S; S.init(NLAT, 4096, F.G, (int)blockIdx.x);
        pg8::EpiC E{(pg8::bf16_t*)(ws + WS_R1), (const pg8::bf16_t*)OA, (pg8::bf16_t*)(ws + WS_R1 + 128 * MiB), (pg8::bf16_t*)OB, late_arg(11), late_arg(13), (LAS float*)(F.lds + RING_BYTES)};
        pg8::gemm_phase<pg8::EpiC, pg8::StaticOrder, true, true>(F.lds, g, S, E);
    }
    GRID_BAR();
    PH(8, {
        pg8::Gemm g{(const pg8::bf16_t*)(ws + WS_R1 + 128 * MiB), (const pg8::bf16_t*)(ws + WS_WTPA), NLAT, 1024, 2048}; pg8::StaticOrder S; S.init(NLAT, 1024, F.G, (int)blockIdx.x);
        pg8::EpiMerge E{(pg8::bf16_t*)(OA + (size_t)NLAT * 1024), (const pg8::bf16_t*)(ws + WS_R1)};
        pg8::gemm_phase<pg8::EpiMerge, pg8::StaticOrder, true, true>(F.lds, g, S, E);
    });
    GRID_BAR();
    PH(10, {
        pg8::Gemm g{(const pg8::bf16_t*)(OA + (size_t)NLAT * 1024), (const pg8::bf16_t*)(ws + WS_WTO), NLAT, 1024, D}; pg8::StaticOrder S; S.init(NLAT, 1024, F.G, (int)blockIdx.x);
        pg8::EpiResid E{(pg8::bf16_t*)(ws + WS_R1), late_arg(0), (const float*)(ws + WS_MOD)};
        pg8::gemm_phase<pg8::EpiResid, pg8::StaticOrder, true, true>(F.lds, g, S, E);
    });
    GRID_BAR();
    PH(11, p10_h2(F));
    GRID_BAR();
    PH(12, {
        pg8::Gemm g{(const pg8::bf16_t*)(ws + WS_H), (const pg8::bf16_t*)(ws + WS_WTF), NLAT, 2048, D}; pg8::StaticOrder S; S.init(NLAT, 2048, F.G, (int)blockIdx.x);
        pg8::EpiScoreT E{(unsigned short*)(ws + WS_R1 + 128 * MiB)};
        pg8::gemm_phase<pg8::EpiScoreT, pg8::StaticOrder, true, true>(F.lds, g, S, E);
    });
    GRID_BAR();
    PH(13, p12_topk(F));
    GRID_BAR();
    PH(14, p13a_peer_u(F));
    GRID_BAR();
    PH(16, p13_peer(F));
}

extern "C" void kernel_launch(void* const* d_in, const int* in_sizes, int n_in, void* d_out, int out_size, void* d_ws, size_t ws_size, hipStream_t stream) {
    static int grid = 0;
    if (grid == 0) {
        if (n_in != 23 || ws_size < WS_END) { fprintf(stderr, "kernel_launch: unexpected n_in %d or ws_size %zu (< %zu)\n", n_in, ws_size, (size_t)WS_END); grid = -1; return; }
        int dev = 0, cus = 0, per_cu = 0;
        if (hipGetDevice(&dev) != hipSuccess || hipDeviceGetAttribute(&cus, hipDeviceAttributeMultiprocessorCount, dev) != hipSuccess) { grid = -1; return; }
        if (hipFuncSetAttribute((const void*)fwd_megakernel, hipFuncAttributeMaxDynamicSharedMemorySize, LDS_BYTES) != hipSuccess) { fprintf(stderr, "kernel_launch: hipFuncSetAttribute failed\n"); grid = -1; return; }
        if (hipOccupancyMaxActiveBlocksPerMultiprocessor(&per_cu, (const void*)fwd_megakernel, NT, LDS_BYTES) != hipSuccess || per_cu < 1) { fprintf(stderr, "kernel_launch: occupancy query says %d\n", per_cu); per_cu = 1; }
        (void)hipGetLastError();
        grid = cus;
    }
    if (grid < 0) return;
    (void)hipMemsetAsync((char*)d_ws + WS_CTL, 0, CTL_ZERO_BYTES, stream);
    Args a{};
    for (int i = 0; i < 23; ++i) a.in[i] = (const float*)d_in[i];
    a.out = (float*)d_out; a.ws = (unsigned char*)d_ws;
    hipLaunchKernelGGL(fwd_megakernel, dim3(grid), dim3(NT), LDS_BYTES, stream, a);
}
```

```cpp
#include <hip/hip_runtime.h>
#include <cstdio>
#include <cstdint>

#define GAS __attribute__((address_space(1)))
#define LAS __attribute__((address_space(3)))
typedef unsigned short bf16;
typedef unsigned v4u __attribute__((ext_vector_type(4)));
typedef unsigned v2u __attribute__((ext_vector_type(2)));
typedef float f32x4 __attribute__((ext_vector_type(4)));
typedef short bf16x8 __attribute__((ext_vector_type(8)));
typedef GAS unsigned gu32;
#define RLX_AGENT __ATOMIC_RELAXED, __HIP_MEMORY_SCOPE_AGENT
#define LDS_WAIT() asm volatile("s_waitcnt lgkmcnt(0)" ::: "memory")
#define VM_WAIT() asm volatile("s_waitcnt vmcnt(0)" ::: "memory")
typedef __bf16 hwbf2_t __attribute__((ext_vector_type(2)));
typedef float hwf2_t __attribute__((ext_vector_type(2)));
__device__ __forceinline__ unsigned f2bf(float f) { return (unsigned)__builtin_bit_cast(unsigned short, (__bf16)f); }
__device__ __forceinline__ unsigned pk2(float lo, float hi) { const hwf2_t v = {lo, hi}; return __builtin_bit_cast(unsigned, __builtin_convertvector(v, hwbf2_t)); }
__device__ __forceinline__ float bf2f(unsigned short b) { return __builtin_bit_cast(float, (unsigned)b << 16); }
__device__ __forceinline__ float bflo(unsigned w) { return __builtin_bit_cast(float, w << 16); }
__device__ __forceinline__ float bfhi(unsigned w) { return __builtin_bit_cast(float, w & 0xffff0000u); }
__device__ __forceinline__ float sigmoidf_(float x) { return __builtin_amdgcn_rcpf(1.f + __builtin_amdgcn_exp2f(x * -1.44269504089f)); }
__device__ __forceinline__ float siluf_(float x) { return x * __builtin_amdgcn_rcpf(1.f + __builtin_amdgcn_exp2f(x * -1.44269504089f)); }
__device__ __forceinline__ float softplusf_(float x) { return x > 20.f ? x : __builtin_amdgcn_logf(1.f + __builtin_amdgcn_exp2f(x * 1.44269504089f)) * 0.69314718056f; }
__device__ __forceinline__ float wave_sum(float v) {
#pragma unroll
    for (int o = 1; o < 64; o <<= 1) v += __shfl_xor(v, o);
    return v;
}
namespace pg8 {
#define PG8_LAS __attribute__((address_space(3)))
typedef unsigned short bf16_t;
typedef short bf16x8 __attribute__((ext_vector_type(8)));
typedef float f32x4 __attribute__((ext_vector_type(4)));
typedef unsigned u32x4 __attribute__((ext_vector_type(4)));
constexpr int BM = 256, BK = 64, HALF = 128, HTB = HALF * BK * 2  , STAGE_BYTES = 8 * HTB, NXCD = 8, WGM = 8;

__host__ __device__ __forceinline__ int lds_byte(int r, int c) { const int st = (r >> 4) * 2 + (c >> 5), rr = r & 15, cc = c & 31, ob = rr * 64 + cc * 2; return st * 1024 + (ob ^ (((ob >> 9) & 1) << 5)); }
__host__ __device__ __forceinline__ void stage_rc(int b, int& R, int& C) { const int st = b / 1024, sb = b % 1024, swz = sb ^ (((sb >> 9) & 1) << 5); R = (st >> 1) * 16 + swz / 64; C = (st & 1) * 32 + (swz % 64) / 2; }
__host__ __device__ __forceinline__ int perm32(int rho) { const int n = rho >> 4, i = rho & 15; return 8 * (i >> 2) + 4 * n + (i & 3); }

struct Unit { int pm, pn; };
struct Gemm { const bf16_t* A; const bf16_t* Bt; int M, N, K; };

struct StaticOrder {
    int nM, nN, nwg, G, c;
    __host__ __device__ void init(int M, int N, int G_, int c_) { nM = M / BM; nN = N / BM; nwg = nM * nN; G = G_; c = c_; }
    __host__ __device__ bool next(int i, Unit& u) const {
        const long L = (long)i * G + c; if (L >= nwg) return false;
        int wgid = (int)L; { const int q = nwg / NXCD, r = nwg % NXCD, xcd = wgid % NXCD, off = wgid / NXCD; wgid = (xcd < r ? xcd * (q + 1) : r * (q + 1) + (xcd - r) * q) + off; }
        const int nig = WGM * nN, gid = wgid / nig, fm = gid * WGM, gsz = (nM - fm) < WGM ? (nM - fm) : WGM;
        u.pm = fm + ((wgid % nig) % gsz); u.pn = (wgid % nig) / gsz; return true;
    }
    __device__ __forceinline__ void a_ready(const Unit&) const {}
    __device__ __forceinline__ void done(const Unit&) const {}
};

__device__ __forceinline__ unsigned cvt_pk_bf16(float lo, float hi) { unsigned r; asm volatile("v_cvt_pk_bf16_f32 %0, %1, %2" : "=v"(r) : "v"(lo), "v"(hi)); return r; }
typedef float f32x2 __attribute__((ext_vector_type(2)));
template <class Epi, class Sched, bool ALIGN_EPI = false, bool SP2 = false>
__device__ __forceinline__ void gemm_phase(PG8_LAS unsigned char* lds, const Gemm g, const Sched& S, const Epi& E) {
    int tid_ = threadIdx.x; asm volatile("" : "+v"(tid_));
    const int tid = tid_, wid = __builtin_amdgcn_readfirstlane(tid >> 6), lane = tid & 63, wr = wid >> 2, wc = wid & 3, fr = lane & 15, fq = lane >> 4;
    const int K = g.K, nt = K / BK;
    unsigned voffA[2], voffB[2];
#pragma unroll
    for (int i = 0; i < 2; ++i) { int R, C; stage_rc(tid * 16 + i * 8192, R, C); const int Rb = Epi::PERM ? ((R & ~31) + perm32(R & 31)) : R;
        voffA[i] = (unsigned)(R * K + C) * 2u; voffB[i] = (unsigned)(Rb * K + C) * 2u; }
    const size_t kstep = (size_t)(BK * 2);
    const size_t hstep = (size_t)HALF * K * 2;
    const size_t tstep = 2 * hstep;
    const unsigned ldsw = (unsigned)wid * 1024u;
    const int aoff = lds_byte(wr * 64 + fr, fq * 8), boff = lds_byte(wc * 32 + fr, fq * 8);
#define PG8_SA(b, h) (((b) * 2 + (h)) * HTB)
#define PG8_SB(b, h) ((4 + (b) * 2 + (h)) * HTB)
#define PG8_STAGE(bufoff, gbase, voff) do { _Pragma("unroll") for (int _i = 0; _i < 2; ++_i) \
        __builtin_amdgcn_global_load_lds((const unsigned*)((const char*)(gbase) + (voff)[_i]), (PG8_LAS unsigned*)(lds + (bufoff) + ldsw + _i * 8192), 16, 0, 0); } while (0)
#define PG8_LDA(dst, b, h) do { _Pragma("unroll") for (int m = 0; m < 4; ++m) _Pragma("unroll") for (int k = 0; k < 2; ++k) dst[m][k] = *(const PG8_LAS bf16x8*)(lds + PG8_SA(b, h) + aoff + m * 2048 + k * 1024); } while (0)
#define PG8_LDB(dst, b, h) do { _Pragma("unroll") for (int n = 0; n < 2; ++n) _Pragma("unroll") for (int k = 0; k < 2; ++k) dst[n][k] = *(const PG8_LAS bf16x8*)(lds + PG8_SB(b, h) + boff + n * 2048 + k * 1024); } while (0)
#define PG8_MMA(ai, bj, At, Bt) do { __builtin_amdgcn_s_setprio(1); _Pragma("unroll") for (int m = 0; m < 4; ++m) _Pragma("unroll") for (int n = 0; n < 2; ++n) _Pragma("unroll") for (int k = 0; k < 2; ++k) \
        acc[ai][bj][m][n] = __builtin_amdgcn_mfma_f32_16x16x32_bf16(Bt[n][k], At[m][k], acc[ai][bj][m][n], 0, 0, 0); __builtin_amdgcn_s_setprio(0); } while (0)
#define PG8_WAIT_V(n) asm volatile("s_waitcnt vmcnt(" #n ")" ::: "memory")
#define PG8_WAIT_L(n) asm volatile("s_waitcnt lgkmcnt(" #n ")" ::: "memory")
#define PG8_BAR __builtin_amdgcn_s_barrier()
#define PG8_SCHED __builtin_amdgcn_sched_barrier(0)
    Unit cur, nxt; int ui = 0;
    if (!S.next(0, cur)) return;
    f32x4 acc[2][2][4][2];
#pragma unroll
    for (int a = 0; a < 2; ++a)
#pragma unroll
        for (int b = 0; b < 2; ++b)
#pragma unroll
            for (int m = 0; m < 4; ++m)
#pragma unroll
                for (int n = 0; n < 2; ++n) acc[a][b][m][n] = (f32x4){0.f, 0.f, 0.f, 0.f};
    bf16x8 At[4][2], B0[2][2], B1[2][2];
    const char* cA = (const char*)g.A + (size_t)cur.pm * tstep; const char* cB = (const char*)g.Bt + (size_t)cur.pn * tstep;
    S.a_ready(cur);
    if constexpr (SP2) {
        PG8_STAGE(PG8_SB(0, 0), cB, voffB); PG8_STAGE(PG8_SB(0, 1), cB + hstep, voffB); PG8_STAGE(PG8_SA(0, 0), cA, voffA); PG8_STAGE(PG8_SA(0, 1), cA + hstep, voffA);
        if (wr == 1) PG8_BAR;
        PG8_WAIT_V(2); PG8_BAR;
        PG8_STAGE(PG8_SB(1, 0), cB + kstep, voffB); PG8_STAGE(PG8_SA(1, 0), cA + kstep, voffA); PG8_STAGE(PG8_SB(1, 1), cB + hstep + kstep, voffB);
        PG8_WAIT_V(6); PG8_BAR;
    } else {
        PG8_STAGE(PG8_SB(0, 0), cB, voffB); PG8_STAGE(PG8_SA(0, 0), cA, voffA); PG8_STAGE(PG8_SB(0, 1), cB + hstep, voffB); PG8_STAGE(PG8_SA(0, 1), cA + hstep, voffA);
        if (wr == 1) PG8_BAR;
        PG8_WAIT_V(4); PG8_BAR;
        PG8_STAGE(PG8_SB(1, 0), cB + kstep, voffB); PG8_STAGE(PG8_SA(1, 0), cA + kstep, voffA); PG8_STAGE(PG8_SB(1, 1), cB + hstep + kstep, voffB);
        PG8_WAIT_V(6); PG8_BAR;
    }
    for (;;) {
        const bool has_next = S.next(ui + 1, nxt);
        const char* nA = has_next ? (const char*)g.A + (size_t)nxt.pm * tstep : cA; const char* nB = has_next ? (const char*)g.Bt + (size_t)nxt.pn * tstep : cB;
        for (int t = 0; t < nt; t += 2) {
            const bool last = (t == nt - 2);
            if constexpr (Epi::MIDK) { if (t == nt / 2) E.midk(acc, cur, wr, wc, fr, fq); }
            const char* a1 = cA + (size_t)(t + 1) * kstep;
            const char* a2 = last ? nA : cA + (size_t)(t + 2) * kstep; const char* b2 = last ? nB : cB + (size_t)(t + 2) * kstep;
            const char* a3 = a2 + kstep; const char* b3 = b2 + kstep;
            if (last && has_next) S.a_ready(nxt);
            if constexpr (SP2) {
            PG8_LDB(B0, 0, 0); PG8_LDB(B1, 0, 1); PG8_SCHED; PG8_LDA(At, 0, 0); PG8_STAGE(PG8_SA(1, 1), a1 + hstep, voffA);
            PG8_WAIT_V(8); PG8_WAIT_L(0); PG8_BAR; PG8_MMA(0, 0, At, B0); PG8_MMA(0, 1, At, B1); PG8_BAR; PG8_SCHED;
            PG8_LDA(At, 0, 1); PG8_STAGE(PG8_SB(0, 0), b2, voffB); PG8_STAGE(PG8_SB(0, 1), b2 + hstep, voffB); PG8_STAGE(PG8_SA(0, 0), a2, voffA);
            PG8_WAIT_V(8); PG8_WAIT_L(0); PG8_BAR; PG8_MMA(1, 0, At, B0); PG8_MMA(1, 1, At, B1); PG8_BAR; PG8_SCHED;
            PG8_LDB(B0, 1, 0); PG8_LDB(B1, 1, 1); PG8_SCHED; PG8_LDA(At, 1, 0); PG8_STAGE(PG8_SA(0, 1), a2 + hstep, voffA);
            PG8_WAIT_V(8); PG8_WAIT_L(0); PG8_BAR; PG8_MMA(0, 0, At, B0); PG8_MMA(0, 1, At, B1); PG8_BAR; PG8_SCHED;
            PG8_LDA(At, 1, 1); PG8_STAGE(PG8_SB(1, 0), b3, voffB); PG8_STAGE(PG8_SB(1, 1), b3 + hstep, voffB); PG8_STAGE(PG8_SA(1, 0), a3, voffA);
            PG8_WAIT_V(8); PG8_WAIT_L(0); PG8_BAR; PG8_MMA(1, 0, At, B0); PG8_MMA(1, 1, At, B1); PG8_BAR; PG8_SCHED;
            } else {
            PG8_LDB(B0, 0, 0); PG8_SCHED; PG8_LDA(At, 0, 0); PG8_STAGE(PG8_SA(1, 1), a1 + hstep, voffA);
            PG8_WAIT_L(8); PG8_BAR; PG8_WAIT_L(0); PG8_MMA(0, 0, At, B0); PG8_BAR; PG8_SCHED;
            PG8_LDB(B1, 0, 1); PG8_STAGE(PG8_SB(0, 0), b2, voffB);
            PG8_BAR; PG8_WAIT_L(0); PG8_MMA(0, 1, At, B1); PG8_BAR;
            PG8_LDA(At, 0, 1); PG8_STAGE(PG8_SA(0, 0), a2, voffA);
            PG8_BAR; PG8_WAIT_L(0); PG8_MMA(1, 0, At, B0); PG8_BAR; PG8_SCHED;
            PG8_STAGE(PG8_SB(0, 1), b2 + hstep, voffB);
            PG8_WAIT_V(6); PG8_BAR; PG8_MMA(1, 1, At, B1); PG8_BAR;
            PG8_LDB(B0, 1, 0); PG8_SCHED; PG8_LDA(At, 1, 0); PG8_STAGE(PG8_SA(0, 1), a2 + hstep, voffA);
            PG8_WAIT_L(8); PG8_BAR; PG8_WAIT_L(0); PG8_MMA(0, 0, At, B0); PG8_BAR; PG8_SCHED;
            PG8_LDB(B1, 1, 1); PG8_STAGE(PG8_SB(1, 0), b3, voffB);
            PG8_BAR; PG8_WAIT_L(0); PG8_MMA(0, 1, At, B1); PG8_BAR;
            PG8_LDA(At, 1, 1); PG8_STAGE(PG8_SA(1, 0), a3, voffA);
            PG8_BAR; PG8_WAIT_L(0); PG8_MMA(1, 0, At, B0); PG8_BAR; PG8_SCHED;
            PG8_STAGE(PG8_SB(1, 1), b3 + hstep, voffB);
            PG8_WAIT_V(6); PG8_BAR; PG8_MMA(1, 1, At, B1); PG8_BAR;
            }
        }
        if constexpr (ALIGN_EPI) { if (wr == 0) PG8_BAR; }
        if constexpr (!Epi::AFTER_DRAIN) { E(acc, cur, wr, wc, fr, fq); S.done(cur); }
        if (!has_next) break;
#pragma unroll
        for (int a = 0; a < 2; ++a)
#pragma unroll
            for (int b = 0; b < 2; ++b)
#pragma unroll
                for (int m = 0; m < 4; ++m)
#pragma unroll
                    for (int n = 0; n < 2; ++n) acc[a][b][m][n] = (f32x4){0.f, 0.f, 0.f, 0.f};
        cur = nxt; cA = nA; cB = nB; ++ui;
        if constexpr (ALIGN_EPI) { if (wr == 1) PG8_BAR; }
    }
    PG8_WAIT_V(0);
    if constexpr (!ALIGN_EPI) { if (wr == 0) PG8_BAR; }
    PG8_BAR;
    if constexpr (Epi::AFTER_DRAIN) { E.fused(acc, cur, wr, wc, fr, fq, lds, wid, lane); S.done(cur); }
#undef PG8_SA
#undef PG8_SB
#undef PG8_STAGE
#undef PG8_LDA
#undef PG8_LDB
#undef PG8_MMA
#undef PG8_WAIT_V
#undef PG8_WAIT_L
#undef PG8_BAR
#undef PG8_SCHED
}
}
#define XB_TMO      128
#define XB_XCNT(j)  (256  + 64 * (j))
#define XB_XSUB(j)  (1280 + 64 * (j))
#define XB_XGEN(j)  (2304 + 64 * (j))
#define XB_TOP      3328
#define XB_TOPGEN   3392
#define XCD_BAR_WORDS 3456
#define XB_SPIN_CAP (1u << 22)

__device__ __forceinline__ unsigned xb_ld(unsigned* p)              { return __hip_atomic_load(p, __ATOMIC_RELAXED, __HIP_MEMORY_SCOPE_AGENT); }
__device__ __forceinline__ unsigned xb_add(unsigned* p, unsigned v) { return __hip_atomic_fetch_add(p, v, __ATOMIC_RELAXED, __HIP_MEMORY_SCOPE_AGENT); }
__device__ __forceinline__ unsigned xb_xcc_id() { return (unsigned)__builtin_amdgcn_s_getreg((3 << 11) | 20) & 0xFu; }
#define XB_SPIN(cond, bar) do { unsigned _sp = 0; while (cond) { __builtin_amdgcn_s_sleep(1); \
    if ((++_sp & 255u) == 0u) { if (xb_ld(&(bar)[XB_TMO])) break; if (_sp > XB_SPIN_CAP) { atomicAdd(&(bar)[XB_TMO], 1u); break; } } } } while (0)

struct XcdBarrier {
    unsigned* bar; unsigned x;
    volatile LAS unsigned* st;
};

__device__ __forceinline__ XcdBarrier xcd_barrier_post(unsigned* bar, volatile LAS unsigned* st) {
    XcdBarrier b; b.bar = bar; b.x = xb_xcc_id(); b.st = st;
    if (threadIdx.x == 0) (void)xb_add(&bar[XB_XCNT(b.x)], 1u);
    return b;
}
__device__ __forceinline__ void xcd_barrier_complete(unsigned* bar, unsigned x, unsigned& nloc, unsigned& nx) {
    const unsigned G = gridDim.x * gridDim.y * gridDim.z;
    unsigned sum, cnt, mine, sp = 0u;
    for (;;) {
        sum = 0u; cnt = 0u; mine = 0u;
#pragma unroll
        for (unsigned j = 0; j < 16; ++j) { const unsigned c = xb_ld(&bar[XB_XCNT(j)]); sum += c; cnt += (c > 0u) ? 1u : 0u; mine = (j == x) ? c : mine; }
        if (sum == G) break;
        __builtin_amdgcn_s_sleep(1);
        if ((++sp & 255u) == 0u) { if (xb_ld(&bar[XB_TMO])) break; if (sp > XB_SPIN_CAP) { atomicAdd(&bar[XB_TMO], 1u); break; } }
    }
    nloc = mine > 0u ? mine : 1u; nx = cnt > 0u ? cnt : 1u;
}

__device__ __forceinline__ void xcd_barrier(const XcdBarrier& b) {
    asm volatile("s_waitcnt vmcnt(0)" ::: "memory");
    __syncthreads();
    if (threadIdx.x == 0) {
        unsigned* bar = b.bar;
        __builtin_amdgcn_s_waitcnt(0);
        unsigned nloc = b.st[0], nx = b.st[1];
        if (nloc == 0u) { xcd_barrier_complete(bar, b.x, nloc, nx); b.st[0] = nloc; b.st[1] = nx; }
        const unsigned old = xb_add(&bar[XB_XSUB(b.x)], 1u);
        const unsigned gen = old / nloc;
        if (old + 1u == (gen + 1u) * nloc) {
            __builtin_amdgcn_fence(__ATOMIC_RELEASE, "agent");
            asm volatile("s_waitcnt vmcnt(0)" ::: "memory");
            const unsigned og = xb_add(&bar[XB_TOP], 1u);
            const unsigned tg = og / nx;
            if (og + 1u == (tg + 1u) * nx) xb_add(&bar[XB_TOPGEN], 1u);
            else XB_SPIN(xb_ld(&bar[XB_TOPGEN]) == tg, bar);
            __builtin_amdgcn_fence(__ATOMIC_ACQUIRE, "agent");
            xb_add(&bar[XB_XGEN(b.x)], 1u);
            asm volatile("s_waitcnt vmcnt(0)" ::: "memory");
        } else {
            XB_SPIN(xb_ld(&bar[XB_XGEN(b.x)]) == gen, bar);
            __builtin_amdgcn_fence(__ATOMIC_ACQUIRE, "agent");
            asm volatile("s_waitcnt vmcnt(0)" ::: "memory");
        }
    }
    __syncthreads();
}
constexpr int NWAVES = 8, NT = 512;
constexpr int D = 1024, NB = 4, SEQ = 8192, CTX = 256;
constexpr int NCTX = NB * CTX;
constexpr int NLAT = NB * SEQ;
constexpr int NROW = NCTX + NLAT;
constexpr int NIN = 11296;
constexpr float EPS = 1e-6f;
constexpr float QSCALE = 0.08838834764831845f;
constexpr int C_QKV = 0, C_GA = 3072, C_AB = 4096, C_QB = 4128, C_GB = 8224, C_MG = 9248;
constexpr int NA = 3328;
constexpr int NPEER = 128;

constexpr size_t MiB = 1u << 20;
constexpr size_t WS_CTL = 0, CTL_ZERO_BYTES = 65536;
constexpr size_t WS_MOD = 65536, WS_LB = 196608, WS_SKB = 262144;
constexpr size_t WS_WTA = 1 * MiB, WS_WTB = 8 * MiB, WS_WTC = 16 * MiB, WS_WTPA = 24 * MiB, WS_WTPB = 26 * MiB, WS_WTO = 28 * MiB, WS_WTQ = 30 * MiB;
constexpr size_t WS_H = 34 * MiB;
constexpr size_t WS_AB = 100 * MiB;
constexpr size_t WS_R1 = 105 * MiB;
constexpr size_t WS_OB = 369 * MiB;
constexpr size_t WS_QKVC = 303 * MiB;
constexpr size_t WS_WTF = 16 * MiB;
__host__ __device__ constexpr size_t ws_eux(int x) { return x < 7 ? (size_t)(1 + 2 * x) * MiB : (size_t)509 * MiB; }
constexpr size_t WS_EV6 = 497 * MiB;
constexpr size_t WS_ESC = 15 * MiB;
constexpr size_t WS_GCB = 501 * MiB;
constexpr size_t WS_END = 511 * MiB;
constexpr int CW_BAR = 1024;

constexpr int RING_BYTES = 131072;
constexpr int LDS_BYTES = 147456;
constexpr int MISC_OFF = LDS_BYTES - 256;

__device__ __forceinline__ const float* late_arg(int i) {
    const __attribute__((address_space(4))) char* kp = (const __attribute__((address_space(4))) char*)__builtin_amdgcn_kernarg_segment_ptr();
    asm volatile("" : "+s"(kp));
    return (const float*)*(const GAS float* const __attribute__((address_space(4)))*)(kp + 8 * i);
}
struct Frame {
    LAS unsigned char* lds;
    int tid, lane, wave, G;
    const float *x, *c, *ctx, *c_ctx, *w_ada, *b_ada, *norm1_w, *w_in, *conv_w, *a_log, *dt_bias, *gdn_norm_w, *lb_logits, *hg_norm_w, *w_pa, *w_pb, *w_o, *norm2_w, *w_query,
        *sub_keys, *expert_u, *expert_v, *final_norm_w;
    float* out; unsigned char* ws;
};

namespace pg8 {
struct EpiStore {
    static constexpr bool PERM = true, AFTER_DRAIN = false, MIDK = false;
    bf16_t* O; int ldc;
    __device__ __forceinline__ void operator()(const f32x4 (&acc)[2][2][4][2], const Unit& u, int wr, int wc, int fr, int fq) const {
        asm volatile("" : "+v"(fr), "+v"(fq));
        const int row0 = u.pm * BM + wr * 64 + fr, col0 = u.pn * BM + wc * 32 + 8 * fq;
#pragma unroll
        for (int ai = 0; ai < 2; ++ai)
#pragma unroll
            for (int m = 0; m < 4; ++m) { bf16_t* rowp = O + (size_t)(row0 + ai * HALF + m * 16) * ldc + col0;
#pragma unroll
                for (int bj = 0; bj < 2; ++bj) { const f32x4 v0 = acc[ai][bj][m][0], v1 = acc[ai][bj][m][1];
                    u32x4 w; w.x = cvt_pk_bf16(v0[0], v0[1]); w.y = cvt_pk_bf16(v0[2], v0[3]); w.z = cvt_pk_bf16(v1[0], v1[1]); w.w = cvt_pk_bf16(v1[2], v1[3]);
                    *(u32x4*)(rowp + bj * HALF) = w; } }
    }
};
struct EpiScoreT {
    static constexpr bool PERM = true, AFTER_DRAIN = false, MIDK = false;
    unsigned short* O;
    __device__ __forceinline__ void operator()(const f32x4 (&acc)[2][2][4][2], const Unit& u, int wr, int wc, int fr, int fq) const {
        asm volatile("" : "+v"(fr), "+v"(fq));
#pragma unroll
        for (int ai = 0; ai < 2; ++ai) {
            const int tb = u.pm * 4 + ai * 2 + wr;
#pragma unroll
            for (int bj = 0; bj < 2; ++bj) {
                unsigned short* bp = O + ((size_t)(tb * 8 + u.pn) * 2 + bj) * 8192 + (wc * 32 + 8 * fq) * 64 + 4 * fr;
#pragma unroll
                for (int n = 0; n < 2; ++n)
#pragma unroll
                    for (int i = 0; i < 4; ++i) {
                        const unsigned lo = (unsigned)__builtin_bit_cast(unsigned short, (_Float16)acc[ai][bj][0][n][i]) | ((unsigned)__builtin_bit_cast(unsigned short, (_Float16)acc[ai][bj][1][n][i]) << 16);
                        const unsigned hi = (unsigned)__builtin_bit_cast(unsigned short, (_Float16)acc[ai][bj][2][n][i]) | ((unsigned)__builtin_bit_cast(unsigned short, (_Float16)acc[ai][bj][3][n][i]) << 16);
                        *(v2u*)(bp + (4 * n + i) * 64) = (v2u){lo, hi}; }
            }
        }
    }
};
struct EpiB {
    static constexpr bool PERM = true, AFTER_DRAIN = false, MIDK = false;
    bf16_t* O; const float* LB;
    __device__ __forceinline__ void operator()(const f32x4 (&acc)[2][2][4][2], const Unit& u, int wr, int wc, int fr, int fq) const {
        asm volatile("" : "+v"(fr), "+v"(fq));
        const int row0 = u.pm * BM + wr * 64 + fr, col0 = u.pn * BM + wc * 32 + 8 * fq;
        const int kind = u.pn < 4 ? 0 : (u.pn < 12 ? 1 : 2);
#pragma unroll
        for (int bj = 0; bj < 2; ++bj) {
            float lb[8];
#pragma unroll
            for (int e = 0; e < 8; ++e) lb[e] = kind == 1 ? LB[(col0 + bj * HALF + e) & 1023] : 0.f;
#pragma unroll
            for (int ai = 0; ai < 2; ++ai)
#pragma unroll
                for (int m = 0; m < 4; ++m) {
                    const int r = row0 + ai * HALF + m * 16; int b, p;
                    if (r < 1024) { b = r >> 8; p = r & 255; } else { const int rr = r - 1024, t = rr & 8191; b = rr >> 13; p = 256 + (t & 63) * 128 + (t >> 6); }
                    const int hh = (u.pn & 3) * 2 + bj, part = u.pn >> 2;
                    bf16_t* rowp = O + ((((size_t)(b * 8 + hh) * 8448 + p) * 4 + part) * 128 + wc * 32 + 8 * fq);
                    float v[8];
#pragma unroll
                    for (int e = 0; e < 4; ++e) { v[e] = acc[ai][bj][m][0][e]; v[4 + e] = acc[ai][bj][m][1][e]; }
                    if (kind == 0) {
#pragma unroll
                        for (int e = 0; e < 8; ++e) v[e] = siluf_(v[e]) * 0.08838834764831845f;
                    } else if (kind == 1) {
#pragma unroll
                        for (int e = 0; e < 8; ++e) v[e] = __builtin_amdgcn_logf(lb[e] + (1.f - lb[e]) * sigmoidf_(v[e]));
                    }
                    u32x4 w; w.x = cvt_pk_bf16(v[0], v[1]); w.y = cvt_pk_bf16(v[2], v[3]); w.z = cvt_pk_bf16(v[4], v[5]); w.w = cvt_pk_bf16(v[6], v[7]);
                    *(u32x4*)rowp = w; }
        }
    }
};
struct EpiC {
    static constexpr bool PERM = true, AFTER_DRAIN = false, MIDK = false;
    bf16_t* G; const bf16_t* OA; bf16_t* OAN; bf16_t* OB; const float* wa; const float* wb; PG8_LAS float* P;
    __device__ __forceinline__ void operator()(const f32x4 (&acc)[2][2][4][2], const Unit& u, int wr, int wc, int fr, int fq) const {
        asm volatile("" : "+v"(fr), "+v"(fq));
        const int row0 = u.pm * BM + wr * 64 + fr;
        if (u.pn >= 8) {
            const int ch0 = (u.pn - 8) * HALF + wc * 32 + 8 * fq;
#pragma unroll
            for (int ai = 0; ai < 2; ++ai)
#pragma unroll
                for (int m = 0; m < 4; ++m) { const size_t ro = (size_t)(row0 + ai * HALF + m * 16) * 1024 + ch0;
                    float rr[8], gb[8];
#pragma unroll
                    for (int e = 0; e < 8; ++e) { const float a = acc[ai][0][m][e >> 2][e & 3], b = acc[ai][1][m][e >> 2][e & 3];
                        const float ea = __builtin_amdgcn_exp2f(a * -1.44269504089f), eb = __builtin_amdgcn_exp2f(fminf(b * -1.44269504089f, 60.f));
                        const float ib = __builtin_amdgcn_rcpf(1.f + eb);
                        rr[e] = (1.f + eb) * __builtin_amdgcn_rcpf(1.f + ea); gb[e] = ib; }
                    *(u32x4*)(G + ro) = (u32x4){cvt_pk_bf16(rr[0], rr[1]), cvt_pk_bf16(rr[2], rr[3]), cvt_pk_bf16(rr[4], rr[5]), cvt_pk_bf16(rr[6], rr[7])};
                    *(u32x4*)(G + (size_t)32768 * 1024 + ro) = (u32x4){cvt_pk_bf16(gb[0], gb[1]), cvt_pk_bf16(gb[2], gb[3]), cvt_pk_bf16(gb[4], gb[5]), cvt_pk_bf16(gb[6], gb[7])}; }
            return;
        }
        const bool isB = (u.pn >> 2) != 0; const float* nw = isB ? wb : wa;
        const int col0 = (u.pn & 3) * BM + wc * 32 + 8 * fq;
        const unsigned BWD = 32768u * 1024u;
        const bf16_t* SRC = isB ? (const bf16_t*)OB : OA;
        const unsigned sb0 = isB ? (unsigned)(2 * (u.pn & 3)) * (8192u * 128u) + wc * 32u + 8u * fq : (unsigned)((2 * (u.pn & 3)) * 4 + wc) * (32768u * 32u) + 8u * fq;
        const unsigned sbj = isB ? 8192u * 128u : 4u * 32768u * 32u;
#pragma unroll
        for (int am = 0; am < 4; ++am) { const int ai = am >> 1, mh = am & 1;
            u32x4 f[2][2], b[2][2];
#pragma unroll
            for (int mm = 0; mm < 2; ++mm) { const unsigned grow = (unsigned)(u.pm * BM + ai * HALF + wr * 64 + (2 * mh + mm) * 16 + fr);
                const unsigned tt = grow & 8191u, rofs = isB ? ((grow >> 13) * (8u * 8192u) + (tt & 63u) * 128u + (tt >> 6)) * 128u : grow * 32u;
#pragma unroll
                for (int bj = 0; bj < 2; ++bj) { const bf16_t* sp = SRC + (sb0 + bj * sbj + rofs); f[mm][bj] = *(const u32x4*)sp; b[mm][bj] = *(const u32x4*)(sp + BWD); } }
#pragma unroll
            for (int mm = 0; mm < 2; ++mm) { const int rl = ai * HALF + wr * 64 + (2 * mh + mm) * 16 + fr;
#pragma unroll
                for (int bj = 0; bj < 2; ++bj) { float ss = 0.f;
#pragma unroll
                    for (int e = 0; e < 4; ++e) { const float x0 = bflo(f[mm][bj][e]) + bflo(b[mm][bj][e]), x1 = bfhi(f[mm][bj][e]) + bfhi(b[mm][bj][e]); ss += x0 * x0 + x1 * x1; }
                    ss += __shfl_xor(ss, 16); ss += __shfl_xor(ss, 32);
                    if (fq == 0) P[(rl * 2 + bj) * 4 + wc] = ss; } }
            asm volatile("" ::: "memory");
        }
        asm volatile("s_waitcnt lgkmcnt(0)" ::: "memory"); __builtin_amdgcn_s_barrier(); asm volatile("" ::: "memory");
#pragma unroll
        for (int am = 0; am < 4; ++am) { const int ai = am >> 1, mh = am & 1;
            u32x4 f[2][2], b[2][2];
#pragma unroll
            for (int mm = 0; mm < 2; ++mm) { const unsigned grow = (unsigned)(u.pm * BM + ai * HALF + wr * 64 + (2 * mh + mm) * 16 + fr);
                const unsigned tt = grow & 8191u, rofs = isB ? ((grow >> 13) * (8u * 8192u) + (tt & 63u) * 128u + (tt >> 6)) * 128u : grow * 32u;
#pragma unroll
                for (int bj = 0; bj < 2; ++bj) { const bf16_t* sp = SRC + (sb0 + bj * sbj + rofs); f[mm][bj] = *(const u32x4*)sp; b[mm][bj] = *(const u32x4*)(sp + BWD); } }
            const f32x4 wlo = *(const f32x4*)(nw + wc * 32 + 8 * fq), whi = *(const f32x4*)(nw + wc * 32 + 8 * fq + 4);
            const float w8[8] = {wlo[0], wlo[1], wlo[2], wlo[3], whi[0], whi[1], whi[2], whi[3]};
#pragma unroll
            for (int mm = 0; mm < 2; ++mm) { const int m = 2 * mh + mm, rl = ai * HALF + wr * 64 + m * 16 + fr; const unsigned grow = (unsigned)(u.pm * BM + rl);
#pragma unroll
                for (int bj = 0; bj < 2; ++bj) {
                    bf16_t* dp = OAN + (grow * 2048u + (isB ? 1024u : 0u) + col0 + bj * HALF);
                    const f32x4 pp = *(const PG8_LAS f32x4*)(P + (rl * 2 + bj) * 4);
                    const float r = rsqrtf(((pp[0] + pp[1]) + (pp[2] + pp[3])) * (1.f / 128.f) + 1e-6f);
                    const f32x4 g0 = acc[ai][bj][m][0], g1 = acc[ai][bj][m][1];
                    float y[8];
#pragma unroll
                    for (int e = 0; e < 4; ++e) { const float gl = e < 2 ? g0[2 * e] : g1[2 * e - 4], gh = e < 2 ? g0[2 * e + 1] : g1[2 * e - 3];
                        y[2 * e] = (bflo(f[mm][bj][e]) + bflo(b[mm][bj][e])) * r * w8[2 * e] * siluf_(gl); y[2 * e + 1] = (bfhi(f[mm][bj][e]) + bfhi(b[mm][bj][e])) * r * w8[2 * e + 1] * siluf_(gh); }
                    u32x4 w; w.x = cvt_pk_bf16(y[0], y[1]); w.y = cvt_pk_bf16(y[2], y[3]); w.z = cvt_pk_bf16(y[4], y[5]); w.w = cvt_pk_bf16(y[6], y[7]);
                    *(u32x4*)dp = w; } }
            asm volatile("" ::: "memory");
        }
    }
};
struct EpiA {
    static constexpr bool PERM = true, AFTER_DRAIN = false, MIDK = false;
    bf16_t* O; float* AB; const float* a_log; const float* dt_bias;
    __device__ __forceinline__ void operator()(const f32x4 (&acc)[2][2][4][2], const Unit& u, int wr, int wc, int fr, int fq) const {
        asm volatile("" : "+v"(fr), "+v"(fq));
        const int row0 = u.pm * BM + wr * 64 + fr;
        if (u.pn < 12) {
            const int col0 = u.pn * BM + wc * 32 + 8 * fq;
#pragma unroll
            for (int ai = 0; ai < 2; ++ai)
#pragma unroll
                for (int m = 0; m < 4; ++m) { bf16_t* rowp = O + (size_t)(row0 + ai * HALF + m * 16) * 3072 + col0;
#pragma unroll
                    for (int bj = 0; bj < 2; ++bj) { const f32x4 v0 = acc[ai][bj][m][0], v1 = acc[ai][bj][m][1];
                        u32x4 w; w.x = cvt_pk_bf16(v0[0], v0[1]); w.y = cvt_pk_bf16(v0[2], v0[3]); w.z = cvt_pk_bf16(v1[0], v1[1]); w.w = cvt_pk_bf16(v1[2], v1[3]);
                        *(u32x4*)(rowp + bj * HALF) = w; } }
        } else if (wc == 0) {
            float al[8], db[8];
#pragma unroll
            for (int hh = 0; hh < 8; ++hh) { al[hh] = fq < 2 ? __expf(a_log[fq * 8 + hh]) : 0.f; db[hh] = fq < 2 ? dt_bias[fq * 8 + hh] : 0.f; }
#pragma unroll
            for (int ai = 0; ai < 2; ++ai)
#pragma unroll
                for (int m = 0; m < 4; ++m) { float* rowp = AB + (size_t)(row0 + ai * HALF + m * 16) * 32 + 8 * fq;
#pragma unroll
                    for (int n = 0; n < 2; ++n) { const f32x4 v = acc[ai][0][m][n]; f32x4 o;
#pragma unroll
                        for (int i = 0; i < 4; ++i) o[i] = fq < 2 ? -al[4 * n + i] * softplusf_(v[i] + db[4 * n + i]) : sigmoidf_(v[i]);
                        *(f32x4*)(rowp + 4 * n) = o; } }
        }
    }
};
struct EpiGate {
    static constexpr bool PERM = true, AFTER_DRAIN = false, MIDK = false;
    bf16_t* O; const bf16_t* G; int goff; const bf16_t* ADD;
    __device__ __forceinline__ void operator()(const f32x4 (&acc)[2][2][4][2], const Unit& u, int wr, int wc, int fr, int fq) const {
        asm volatile("" : "+v"(fr), "+v"(fq));
        const int row0 = u.pm * BM + wr * 64 + fr, col0 = u.pn * BM + wc * 32 + 8 * fq;
#pragma unroll
        for (int ai = 0; ai < 2; ++ai) {
            u32x4 g[4][2], a[4][2];
#pragma unroll
            for (int m = 0; m < 4; ++m)
#pragma unroll
                for (int bj = 0; bj < 2; ++bj) { const size_t row = (size_t)(row0 + ai * HALF + m * 16); const int col = col0 + bj * HALF;
                    g[m][bj] = *(const u32x4*)(G + row * 2048 + goff + col);
                    a[m][bj] = ADD ? *(const u32x4*)(ADD + row * 1024 + col) : (u32x4){0u, 0u, 0u, 0u}; }
#pragma unroll
            for (int m = 0; m < 4; ++m)
#pragma unroll
                for (int bj = 0; bj < 2; ++bj) { const size_t row = (size_t)(row0 + ai * HALF + m * 16); const int col = col0 + bj * HALF;
                    const u32x4 gg = g[m][bj], aa = a[m][bj];
                    const f32x4 v0 = acc[ai][bj][m][0], v1 = acc[ai][bj][m][1];
                    float r[8];
                    r[0] = sigmoidf_(bflo(gg.x)) * v0[0] + bflo(aa.x); r[1] = sigmoidf_(bfhi(gg.x)) * v0[1] + bfhi(aa.x);
                    r[2] = sigmoidf_(bflo(gg.y)) * v0[2] + bflo(aa.y); r[3] = sigmoidf_(bfhi(gg.y)) * v0[3] + bfhi(aa.y);
                    r[4] = sigmoidf_(bflo(gg.z)) * v1[0] + bflo(aa.z); r[5] = sigmoidf_(bfhi(gg.z)) * v1[1] + bfhi(aa.z);
                    r[6] = sigmoidf_(bflo(gg.w)) * v1[2] + bflo(aa.w); r[7] = sigmoidf_(bfhi(gg.w)) * v1[3] + bfhi(aa.w);
                    u32x4 w; w.x = cvt_pk_bf16(r[0], r[1]); w.y = cvt_pk_bf16(r[2], r[3]); w.z = cvt_pk_bf16(r[4], r[5]); w.w = cvt_pk_bf16(r[6], r[7]);
                    *(u32x4*)(O + row * 1024 + col) = w; }
            asm volatile("" ::: "memory");
        }
    }
};
struct EpiResid {
    static constexpr bool PERM = true, AFTER_DRAIN = false, MIDK = false;
    bf16_t* O; const float* X; const float* MOD;
    __device__ __forceinline__ void operator()(const f32x4 (&acc)[2][2][4][2], const Unit& u, int wr, int wc, int fr, int fq) const {
        asm volatile("" : "+v"(fr), "+v"(fq));
        const int row0 = u.pm * BM + wr * 64 + fr, col0 = u.pn * BM + wc * 32 + 8 * fq;
        const float* g1 = MOD + (size_t)((u.pm * BM) >> 13) * 6144 + 2048;
        f32x4 gv[2][2];
#pragma unroll
        for (int bj = 0; bj < 2; ++bj) { gv[bj][0] = *(const f32x4*)(g1 + col0 + bj * HALF); gv[bj][1] = *(const f32x4*)(g1 + col0 + bj * HALF + 4); }
#pragma unroll
        for (int ai = 0; ai < 2; ++ai)
#pragma unroll
            for (int mh = 0; mh < 2; ++mh) {
                f32x4 xv[2][2][2];
#pragma unroll
                for (int mm = 0; mm < 2; ++mm)
#pragma unroll
                    for (int bj = 0; bj < 2; ++bj) { const size_t off = (size_t)(row0 + ai * HALF + (2 * mh + mm) * 16) * 1024 + col0 + bj * HALF;
                        xv[mm][bj][0] = *(const f32x4*)(X + off); xv[mm][bj][1] = *(const f32x4*)(X + off + 4); }
#pragma unroll
                for (int mm = 0; mm < 2; ++mm)
#pragma unroll
                    for (int bj = 0; bj < 2; ++bj) { const int m = 2 * mh + mm; const size_t off = (size_t)(row0 + ai * HALF + m * 16) * 1024 + col0 + bj * HALF;
                        const f32x4 y0 = xv[mm][bj][0] + gv[bj][0] * acc[ai][bj][m][0], y1 = xv[mm][bj][1] + gv[bj][1] * acc[ai][bj][m][1];
                        *(u32x4*)(O + off) = (u32x4){cvt_pk_bf16(y0[0], y0[1]), cvt_pk_bf16(y0[2], y0[3]), cvt_pk_bf16(y1[0], y1[1]), cvt_pk_bf16(y1[2], y1[3])}; }
                asm volatile("" ::: "memory");
            }
    }
};
struct EpiMerge {
    static constexpr bool PERM = true, AFTER_DRAIN = false, MIDK = true;
    bf16_t* O; const bf16_t* G;
    __device__ __forceinline__ void midk(f32x4 (&acc)[2][2][4][2], const Unit& u, int wr, int wc, int fr, int fq) const {
        asm volatile("" : "+v"(fr), "+v"(fq));
        const int row0 = u.pm * BM + wr * 64 + fr, col0 = u.pn * BM + wc * 32 + 8 * fq;
#pragma unroll
        for (int ai = 0; ai < 2; ++ai) {
            u32x4 ga[4][2];
#pragma unroll
            for (int m = 0; m < 4; ++m)
#pragma unroll
                for (int bj = 0; bj < 2; ++bj) ga[m][bj] = *(const u32x4*)(G + (size_t)(row0 + ai * HALF + m * 16) * 1024 + col0 + bj * HALF);
#pragma unroll
            for (int m = 0; m < 4; ++m)
#pragma unroll
                for (int bj = 0; bj < 2; ++bj)
#pragma unroll
                    for (int e = 0; e < 4; ++e) {
                        const float r0 = bflo(ga[m][bj][e]), r1 = bfhi(ga[m][bj][e]);
                        if (e < 2) { acc[ai][bj][m][0][2 * e] *= r0; acc[ai][bj][m][0][2 * e + 1] *= r1; } else { acc[ai][bj][m][1][2 * e - 4] *= r0; acc[ai][bj][m][1][2 * e - 3] *= r1; }
                    }
            asm volatile("" ::: "memory");
        }
    }
    __device__ __forceinline__ void operator()(const f32x4 (&acc)[2][2][4][2], const Unit& u, int wr, int wc, int fr, int fq) const {
        asm volatile("" : "+v"(fr), "+v"(fq));
        const int row0 = u.pm * BM + wr * 64 + fr, col0 = u.pn * BM + wc * 32 + 8 * fq;
#pragma unroll
        for (int ai = 0; ai < 2; ++ai) {
            u32x4 g[4][2];
#pragma unroll
            for (int m = 0; m < 4; ++m)
#pragma unroll
                for (int bj = 0; bj < 2; ++bj) g[m][bj] = *(const u32x4*)(G + (size_t)32768 * 1024 + (size_t)(row0 + ai * HALF + m * 16) * 1024 + col0 + bj * HALF);
#pragma unroll
            for (int m = 0; m < 4; ++m)
#pragma unroll
                for (int bj = 0; bj < 2; ++bj) { const u32x4 gg = g[m][bj]; const f32x4 v0 = acc[ai][bj][m][0], v1 = acc[ai][bj][m][1];
                    u32x4 w; w.x = cvt_pk_bf16(bflo(gg.x) * v0[0], bfhi(gg.x) * v0[1]); w.y = cvt_pk_bf16(bflo(gg.y) * v0[2], bfhi(gg.y) * v0[3]);
                    w.z = cvt_pk_bf16(bflo(gg.z) * v1[0], bfhi(gg.z) * v1[1]); w.w = cvt_pk_bf16(bflo(gg.w) * v1[2], bfhi(gg.w) * v1[3]);
                    *(u32x4*)(O + (size_t)(row0 + ai * HALF + m * 16) * 1024 + col0 + bj * HALF) = w; }
            asm volatile("" ::: "memory");
        }
    }
};
}

__device__ __forceinline__ void p0_transpose_item(const float* W, int pitch, int ncols, int K, bf16* WT, LAS float* scr, int item, int lane, int ldk = 0) {
    if (ldk == 0) ldk = K;
    const int nblk = ncols / 32, kb = item / nblk, nb = item % nblk, k0 = 64 * kb, n0 = 32 * nb;
#pragma unroll 8
    for (int i = 0; i < 32; ++i) { const int kk = 2 * i + (lane >> 5); scr[kk * 33 + (lane & 31)] = W[(size_t)(k0 + kk) * pitch + n0 + (lane & 31)]; }
    LDS_WAIT(); asm volatile("" ::: "memory");
    const int c = lane & 7;
#pragma unroll
    for (int j = 0; j < 4; ++j) { const int n = (lane >> 3) + 8 * j; const LAS float* s = scr + (8 * c) * 33 + n;
        v4u o; o.x = pk2(s[0 * 33], s[1 * 33]); o.y = pk2(s[2 * 33], s[3 * 33]); o.z = pk2(s[4 * 33], s[5 * 33]); o.w = pk2(s[6 * 33], s[7 * 33]);
        *(v4u*)(WT + (size_t)(n0 + n) * ldk + k0 + 8 * c) = o; }
    LDS_WAIT(); asm volatile("" ::: "memory");
}
__device__ __forceinline__ void p0_prologue(Frame& F) {
    {
        LAS float* sc = (LAS float*)F.lds;
        LAS float* red = (LAS float*)(F.lds + 32768);
        if ((int)blockIdx.x < 192) {
            for (int i = F.tid; i < 5120; i += NT) { const int r = i >> 10, k = i & 1023; const float v = r < 4 ? F.c[r * 1024 + k] : F.c_ctx[k]; sc[i] = siluf_(v); }
            __syncthreads();
            float* MOD = (float*)(F.ws + WS_MOD);
            for (int grp = blockIdx.x; grp < 192; grp += F.G) {
                const int cl = F.lane & 31, kh = F.lane >> 5, col = grp * 32 + cl, k0 = F.wave * 128 + kh * 64;
                float acc[5] = {0.f, 0.f, 0.f, 0.f, 0.f};
#pragma unroll 16
                for (int k = k0; k < k0 + 64; ++k) { const float w = F.w_ada[(size_t)k * 6144 + col];
#pragma unroll
                    for (int r = 0; r < 5; ++r) acc[r] = fmaf(sc[r * 1024 + k], w, acc[r]); }
#pragma unroll
                for (int r = 0; r < 5; ++r) red[((F.wave * 2 + kh) * 5 + r) * 32 + cl] = acc[r];
                __syncthreads();
                if (F.tid < 160) { const int r = F.tid >> 5, c2 = F.tid & 31; float s2 = 0.f;
#pragma unroll
                    for (int q = 0; q < 16; ++q) s2 += red[(q * 5 + r) * 32 + c2];
                    MOD[r * 6144 + grp * 32 + c2] = s2 + F.b_ada[grp * 32 + c2]; }
                __syncthreads();
            }
        }
        if ((int)blockIdx.x == 200 % F.G) { float* LB = (float*)(F.ws + WS_LB); for (int i = F.tid; i < 1024; i += NT) LB[i] = sigmoidf_(F.lb_logits[i] - F.lb_logits[1024 + i]); }
    }
}

__device__ __forceinline__ void p0_weights(Frame& F) {
    LAS float* scr = (LAS float*)(F.lds + 49152 + F.wave * 8448);
    const int gw = blockIdx.x * NWAVES + F.wave, NGW = F.G * NWAVES;
    bf16* WTA = (bf16*)(F.ws + WS_WTA); bf16* WTB = (bf16*)(F.ws + WS_WTB); bf16* WTC = (bf16*)(F.ws + WS_WTC);
    constexpr int I0 = 16 * 96, I1 = 16 * 1, I2 = 16 * 128, I3 = 16 * 32, I4 = 16 * 32, I5 = 16 * 64, I6 = 16 * 32, I7 = 16 * 32, I8 = 16 * 32, I9 = 16 * 64;
    constexpr int NITEMS = I0 + I1 + I2 + I3 + I4 + I5 + I6 + I7 + I8 + I9;
    for (int it = NGW - 1 - gw; it < I0 + I1 + I2; it += NGW) {
        int r = it;
        if (r < I0) { p0_transpose_item(F.w_in + C_QKV, NIN, 3072, D, WTA, scr, r, F.lane); continue; } r -= I0;
        if (r < I1) { p0_transpose_item(F.w_in + C_AB, NIN, 32, D, WTA + (size_t)3072 * D, scr, r, F.lane); continue; } r -= I1;
        p0_transpose_item(F.w_in + C_QB, NIN, 4096, D, WTB, scr, r, F.lane);
    }
    { v4u* z = (v4u*)(WTA + (size_t)3104 * D); for (int i = blockIdx.x * NT + F.tid; i < 28672; i += F.G * NT) z[i] = (v4u){0u, 0u, 0u, 0u}; }
}

__device__ __forceinline__ void norm_mod_row_bf16(const float* src, const float* w, const float* shift, const float* scale, bf16* dst, int lane) {
    const f32x4* xr = (const f32x4*)src + lane; f32x4 v[4]; float s = 0.f;
#pragma unroll
    for (int j = 0; j < 4; ++j) { v[j] = xr[64 * j]; s += (v[j].x * v[j].x + v[j].y * v[j].y) + (v[j].z * v[j].z + v[j].w * v[j].w); }
    const float r = rsqrtf(wave_sum(s) * (1.f / D) + EPS);
    unsigned long long* o8 = (unsigned long long*)dst + lane;
#pragma unroll
    for (int j = 0; j < 4; ++j) { const f32x4 ww = ((const f32x4*)w)[64 * j + lane], sh = ((const f32x4*)shift)[64 * j + lane], sc = ((const f32x4*)scale)[64 * j + lane];
        const f32x4 y = v[j] * r * ww * (sc + 1.f) + sh;
        o8[64 * j] = (unsigned long long)pk2(y.x, y.y) | ((unsigned long long)pk2(y.z, y.w) << 32); }
}
__device__ __forceinline__ void p1_h(Frame& F) {
    const int gw = blockIdx.x * NWAVES + F.wave, NGW = F.G * NWAVES;
    const float* MOD = (const float*)(F.ws + WS_MOD); bf16* H = (bf16*)(F.ws + WS_H);
    for (int r = gw; r < NROW; r += NGW) {
        const float* src; const float* md;
        if (r < NCTX) { src = F.ctx + (size_t)r * D; md = MOD + 4 * 6144; } else { src = F.x + (size_t)(r - NCTX) * D; md = MOD + (size_t)((r - NCTX) >> 13) * 6144; }
        norm_mod_row_bf16(src, F.norm1_w, md, md + 1024, H + (size_t)r * D, F.lane);
    }
    p0_weights(F);
}

typedef short s16x4 __attribute__((ext_vector_type(4)));
__device__ __forceinline__ bf16x8 ld_row(const LAS unsigned char* img, int pitch, int r0, int k0, int lane) {
    return *(const LAS bf16x8*)(img + (r0 + (lane & 15)) * pitch + (k0 + 8 * (lane >> 4)) * 2);
}
__device__ __forceinline__ bf16x8 ld_tr(const LAS unsigned char* img, int pitch, int k0, int n0, int lane) {
    const int g = lane >> 4, q = (lane >> 2) & 3, p = lane & 3;
    const LAS unsigned char* a0 = img + (k0 + 8 * g + q) * pitch + (n0 + 4 * p) * 2;
    const s16x4 lo = __builtin_amdgcn_ds_read_tr16_b64_v4i16((LAS s16x4*)a0);
    const s16x4 hi = __builtin_amdgcn_ds_read_tr16_b64_v4i16((LAS s16x4*)(a0 + 4 * pitch));
    bf16x8 r; r[0] = lo[0]; r[1] = lo[1]; r[2] = lo[2]; r[3] = lo[3]; r[4] = hi[0]; r[5] = hi[1]; r[6] = hi[2]; r[7] = hi[3];
    return r;
}
#define MFMA16(a, b, c) __builtin_amdgcn_mfma_f32_16x16x32_bf16((a), (b), (c), 0, 0, 0)


#define LDS_BARRIER() do { asm volatile("s_waitcnt lgkmcnt(0)" ::: "memory"); __builtin_amdgcn_s_barrier(); asm volatile("" ::: "memory"); } while (0)
__device__ __forceinline__ void p2b_gdn_prep(Frame& F) {
    const bf16* QKV = (const bf16*)(F.ws + WS_R1); bf16* QKVC = (bf16*)(F.ws + WS_QKVC); const float* conv_w = late_arg(8);
    const int gw = blockIdx.x * NWAVES + F.wave, NGW = F.G * NWAVES, lane = F.lane;
    for (int item = gw; item < (NROW / 64) * 6; item += NGW) {
        const int rb = item / 6, c6 = item - rb * 6, row0 = rb * 64, ch0 = c6 * 512 + lane * 8;
        int seg0, seg1;
        if (row0 < NCTX) { seg0 = row0 & ~(CTX - 1); seg1 = seg0 + CTX; } else { seg0 = NCTX + ((row0 - NCTX) & ~(SEQ - 1)); seg1 = seg0 + SEQ; }
        float cw[3][8];
#pragma unroll
        for (int j = 0; j < 3; ++j) { const f32x4 a = *(const f32x4*)(conv_w + j * 3072 + ch0), b = *(const f32x4*)(conv_w + j * 3072 + ch0 + 4);
            cw[j][0] = a.x; cw[j][1] = a.y; cw[j][2] = a.z; cw[j][3] = a.w; cw[j][4] = b.x; cw[j][5] = b.y; cw[j][6] = b.z; cw[j][7] = b.w; }
        const v4u zero4 = (v4u){0u, 0u, 0u, 0u};
        const float nscale = c6 < 2 ? QSCALE : 1.f;
        v4u win[10];
        win[0] = row0 > seg0 ? *(const v4u*)(QKV + (size_t)(row0 - 1) * 3072 + ch0) : zero4;
        win[1] = *(const v4u*)(QKV + (size_t)row0 * 3072 + ch0);
        for (int g = 0; g < 8; ++g) {
#pragma unroll
            for (int e = 0; e < 8; ++e) { const int row = row0 + 8 * g + e + 1; win[2 + e] = row < seg1 ? *(const v4u*)(QKV + (size_t)row * 3072 + ch0) : zero4; }
#pragma unroll
            for (int rr = 0; rr < 8; ++rr) {
                const int row = row0 + 8 * g + rr;
                const v4u prev = win[rr], cur = win[rr + 1], nxt = win[rr + 2];
                float y[8]; float ss = 0.f;
#pragma unroll
                for (int e = 0; e < 4; ++e) {
                    const unsigned pw = prev[e], cwd = cur[e], nw = nxt[e];
                    const float a0 = cw[0][2 * e] * bflo(pw) + cw[1][2 * e] * bflo(cwd) + cw[2][2 * e] * bflo(nw);
                    const float a1 = cw[0][2 * e + 1] * bfhi(pw) + cw[1][2 * e + 1] * bfhi(cwd) + cw[2][2 * e + 1] * bfhi(nw);
                    y[2 * e] = siluf_(a0); y[2 * e + 1] = siluf_(a1);
                    ss += y[2 * e] * y[2 * e] + y[2 * e + 1] * y[2 * e + 1];
                }
                float sc = 1.f;
                if (c6 < 4) {
                    ss += __shfl_xor(ss, 1); ss += __shfl_xor(ss, 2); ss += __shfl_xor(ss, 4); ss += __shfl_xor(ss, 8);
                    sc = rsqrtf(ss + EPS) * nscale;
                }
                v4u o; o.x = pk2(y[0] * sc, y[1] * sc); o.y = pk2(y[2] * sc, y[3] * sc); o.z = pk2(y[4] * sc, y[5] * sc); o.w = pk2(y[6] * sc, y[7] * sc);
                { int bb, tp; if (row < NCTX) { bb = row >> 8; tp = row & 255; } else { const int rr = row - NCTX; bb = rr >> 13; tp = 256 + (rr & 8191); }
                  const int part = ch0 >> 10, hd = (ch0 >> 7) & 7, cc = ch0 & 127;
                  *(v4u*)(QKVC + ((((size_t)(bb * 8 + hd) * 8448 + tp) * 3 + part) * 128 + cc)) = o; }
            }
            win[0] = win[8]; win[1] = win[9];
        }
    }
}

__device__ __forceinline__ size_t gdn_row(int b, int dir, int ci, int i) {
    const int seg = ci < 4 ? 0 : 1, cs = seg == 0 ? ci : ci - 4, nch = seg == 0 ? 4 : 128, lo = (dir == 0 ? cs : nch - 1 - cs) * 64;
    return (seg == 0 ? (size_t)b * CTX : (size_t)NCTX + (size_t)b * SEQ) + (dir == 0 ? lo + i : lo + 63 - i);
}
__device__ __forceinline__ int gdn_pos(int dir, int ci, int i) {
    const int seg = ci < 4 ? 0 : 1, cs = seg == 0 ? ci : ci - 4, nch = seg == 0 ? 4 : 128, lo = (dir == 0 ? cs : nch - 1 - cs) * 64;
    return seg * 256 + (dir == 0 ? lo + i : lo + 63 - i);
}
__device__ __forceinline__ void p3a_gdn_tw(Frame& F) {
    constexpr int PK = 272, PP = 144;
    constexpr int GRP_BYTES = 2 * 64 * PK + 3 * 64 * PP + 4096 + 512;
    const int tid = F.tid, lane = F.lane, w = F.wave, fr = lane & 15, fq = lane >> 4;
    const int g = w >> 2, wl = w & 3, tg = tid & 255;
    LAS unsigned char* base = F.lds + g * GRP_BYTES;
    LAS unsigned char* Kb = base;
    LAS unsigned char* KBG = Kb + 64 * PK;
    LAS unsigned char* Wn = Kb;
    LAS unsigned char* Mb = KBG + 64 * PK;
    LAS unsigned char* Tm = Mb + 64 * PP;
    LAS unsigned char* TMP = Tm + 64 * PP;
    LAS float* Md = (LAS float*)(TMP + 64 * PP);
    LAS float* gcs = Md + 1024;
    LAS float* bet = gcs + 64;
    const bf16* QKVC = (const bf16*)(F.ws + WS_QKVC); const float* AB = (const float*)(F.ws + WS_AB);
    unsigned char* TW = F.ws + WS_R1;
    const int li = tg >> 2, seg4 = tg & 3;
    __syncthreads();
    for (int i = tg; i < 64 * PP / 4; i += 256) ((LAS unsigned*)TMP)[i] = 0u;
    v4u k0, k1, k2, k3; float gi = 0.f, bi = 0.f;
#define TW_LOAD(cp_) do { const int ch_ = (cp_) / 132, ci_ = (cp_) - ch_ * 132, b_ = ch_ >> 4, h_ = (ch_ >> 1) & 7, dir_ = ch_ & 1; \
        { const bf16* rp_ = QKVC + (((size_t)(b_ * 8 + h_) * 8448 + gdn_pos(dir_, ci_, li)) * 3 + 1) * 128 + seg4 * 32; k0 = *(const v4u*)rp_; k1 = *(const v4u*)(rp_ + 8); k2 = *(const v4u*)(rp_ + 16); k3 = *(const v4u*)(rp_ + 24); } \
        if (wl == 0) { const size_t row_ = gdn_row(b_, dir_, ci_, lane); gi = AB[row_ * 32 + dir_ * 8 + h_]; bi = AB[row_ * 32 + 16 + dir_ * 8 + h_]; } } while (0)
    constexpr int NPAIR = 8448 / 2;
    if ((int)blockIdx.x < NPAIR) TW_LOAD(2 * (int)blockIdx.x + g);
    for (int pr = blockIdx.x; pr < NPAIR; pr += F.G) {
        const int cp = 2 * pr + g;
        if (wl == 0) {
            float x = gi;
#pragma unroll
            for (int o = 1; o < 64; o <<= 1) { const float y = __shfl_up(x, o); if (lane >= o) x += y; }
            gcs[lane] = x; bet[lane] = bi;
        }
        for (int i = tg; i < 64 * PP / 16; i += 256) ((LAS v4u*)Tm)[i] = (v4u){0u, 0u, 0u, 0u};
        __syncthreads();
        {
            const float fac = bet[li] * __expf(gcs[li]);
            const int o = li * PK + seg4 * 64;
            *(LAS v4u*)(Kb + o) = k0; *(LAS v4u*)(Kb + o + 16) = k1; *(LAS v4u*)(Kb + o + 32) = k2; *(LAS v4u*)(Kb + o + 48) = k3;
#define SC4(k_) ((v4u){pk2(bflo(k_.x) * fac, bfhi(k_.x) * fac), pk2(bflo(k_.y) * fac, bfhi(k_.y) * fac), pk2(bflo(k_.z) * fac, bfhi(k_.z) * fac), pk2(bflo(k_.w) * fac, bfhi(k_.w) * fac)})
            *(LAS v4u*)(KBG + o) = SC4(k0); *(LAS v4u*)(KBG + o + 16) = SC4(k1); *(LAS v4u*)(KBG + o + 32) = SC4(k2); *(LAS v4u*)(KBG + o + 48) = SC4(k3);
#undef SC4
        }
        __syncthreads();
        if (pr + F.G < NPAIR) TW_LOAD(2 * (pr + F.G) + g);
#pragma unroll
        for (int q = 0; q < 3; ++q) {
            const int tq = wl + 4 * q;
            if (tq < 10) {
                const int it = tq < 4 ? 3 : tq < 7 ? 2 : tq < 9 ? 1 : 0, jt = tq < 4 ? tq : tq < 7 ? tq - 4 : tq < 9 ? tq - 7 : 0;
                f32x4 accK = (f32x4){0.f, 0.f, 0.f, 0.f};
#pragma unroll
                for (int ks = 0; ks < 4; ++ks) accK = MFMA16(ld_row(Kb, PK, it * 16, ks * 32, lane), ld_row(Kb, PK, jt * 16, ks * 32, lane), accK);
                const float gj = gcs[jt * 16 + fr];
#pragma unroll
                for (int r = 0; r < 4; ++r) {
                    const int il = 4 * fq + r;
                    const float gr = gcs[it * 16 + il], br = bet[it * 16 + il];
                    const bool lower = jt < it || il > fr;
                    const float m = lower ? br * accK[r] * __expf(gr - gj) : 0.f;
                    *(LAS unsigned short*)(Mb + (it * 16 + il) * PP + (jt * 16 + fr) * 2) = (unsigned short)f2bf(m);
                    if (jt == it) Md[(it * 16 + il) * 16 + fr] = m;
                }
            }
        }
        __syncthreads();
        if (wl == 0) {
            const int bk = lane >> 4, c = lane & 15;
            float x[16];
#pragma unroll
            for (int r = 0; r < 16; ++r) x[r] = r == c ? 1.f : 0.f;
#pragma unroll
            for (int m = 0; m < 15; ++m) {
#pragma unroll
                for (int r = m + 1; r < 16; ++r) x[r] = fmaf(-Md[(bk * 16 + r) * 16 + m], x[m], x[r]);
            }
#pragma unroll
            for (int r = 0; r < 16; ++r) *(LAS unsigned short*)(Tm + (bk * 16 + r) * PP + (bk * 16 + c) * 2) = (unsigned short)f2bf(x[r]);
        }
        __syncthreads();
        if (wl < 2) {
            const int o32 = 32 * wl;
            const f32x4 acc = MFMA16(ld_row(Mb, PP, o32 + 16, o32, lane), ld_tr(Tm, PP, o32, o32, lane), ((f32x4){0.f, 0.f, 0.f, 0.f}));
#pragma unroll
            for (int r = 0; r < 4; ++r) *(LAS unsigned short*)(TMP + (o32 + 16 + 4 * fq + r) * PP + (o32 + fr) * 2) = (unsigned short)f2bf(acc[r]);
        }
        __syncthreads();
        if (wl < 2) {
            const int o32 = 32 * wl;
            const f32x4 acc = MFMA16(ld_row(Tm, PP, o32 + 16, o32, lane), ld_tr(TMP, PP, o32, o32, lane), ((f32x4){0.f, 0.f, 0.f, 0.f}));
#pragma unroll
            for (int r = 0; r < 4; ++r) *(LAS unsigned short*)(Tm + (o32 + 16 + 4 * fq + r) * PP + (o32 + fr) * 2) = (unsigned short)f2bf(-acc[r]);
        }
        __syncthreads();
        {
            const int yi = wl >> 1, yj = wl & 1;
            const f32x4 acc = MFMA16(ld_row(Mb, PP, 32 + 16 * yi, 0, lane), ld_tr(Tm, PP, 0, 16 * yj, lane), ((f32x4){0.f, 0.f, 0.f, 0.f}));
#pragma unroll
            for (int r = 0; r < 4; ++r) *(LAS unsigned short*)(TMP + (32 + 16 * yi + 4 * fq + r) * PP + (16 * yj + fr) * 2) = (unsigned short)f2bf(acc[r]);
        }
        __syncthreads();
        {
            const int yi = wl >> 1, yj = wl & 1;
            const f32x4 acc = MFMA16(ld_row(Tm, PP, 32 + 16 * yi, 32, lane), ld_tr(TMP, PP, 32, 16 * yj, lane), ((f32x4){0.f, 0.f, 0.f, 0.f}));
#pragma unroll
            for (int r = 0; r < 4; ++r) *(LAS unsigned short*)(Tm + (32 + 16 * yi + 4 * fq + r) * PP + (16 * yj + fr) * 2) = (unsigned short)f2bf(-acc[r]);
        }
        __syncthreads();
        {
            const int it = wl;
            bf16x8 at[2];
            at[0] = ld_row(Tm, PP, it * 16, 0, lane); at[1] = ld_row(Tm, PP, it * 16, 32, lane);
            const int nks = it >= 2 ? 2 : 1;
#pragma unroll
            for (int dt = 0; dt < 8; ++dt) {
                f32x4 acc = (f32x4){0.f, 0.f, 0.f, 0.f};
#pragma unroll
                for (int ks = 0; ks < 2; ++ks) if (ks < nks) acc = MFMA16(at[ks], ld_tr(KBG, PK, ks * 32, dt * 16, lane), acc);
#pragma unroll
                for (int r = 0; r < 4; ++r) *(LAS unsigned short*)(Wn + (it * 16 + 4 * fq + r) * PK + (dt * 16 + fr) * 2) = (unsigned short)f2bf(-acc[r]);
            }
        }
        __syncthreads();
        {
            if (tg < 128) ((float*)(F.ws + WS_GCB))[(size_t)cp * 128 + tg] = gcs[tg];
            unsigned char* dst = TW + (size_t)cp * 24576;
            *(v4u*)(dst + li * 128 + seg4 * 32) = *(const LAS v4u*)(Tm + li * PP + seg4 * 32);
            *(v4u*)(dst + li * 128 + seg4 * 32 + 16) = *(const LAS v4u*)(Tm + li * PP + seg4 * 32 + 16);
#pragma unroll
            for (int q = 0; q < 4; ++q) *(v4u*)(dst + 8192 + li * 256 + seg4 * 64 + 16 * q) = *(const LAS v4u*)(Wn + li * PK + seg4 * 64 + 16 * q);
        }
        __syncthreads();
    }
#undef TW_LOAD
}

struct GdnCtx { LAS unsigned char *Kb, *Qb, *Wn, *VB, *Tm, *QKd, *St, *Vt, *Vst; LAS float *gcs, *bet; const bf16* QKVC; const float* GCB; const unsigned char* TW; bf16* OA; bf16* JUNK;
                int lane, w, fr, fq, li, seg8, it, half, b, h, dir, sl, chain;
                __amdgpu_buffer_rsrc_t rQ, rT, rG, rO, rJ; unsigned vq, vv, vt, vw, vgb, vgg, vo, vj; };
struct GdnRegs { v4u q0, q1, k0, k1, t0, w0, w1; v2u vv; float gi, bi; };
__device__ __forceinline__ void gdn_load(const GdnCtx& C, GdnRegs& R, int ci) {
    const int seg = ci < 4 ? 0 : 1, cs = seg == 0 ? ci : ci - 4, nch = seg == 0 ? 4 : 128, lo = (C.dir == 0 ? cs : nch - 1 - cs) * 64;
    const unsigned sq = (unsigned)(((C.b * 8 + C.h) * 8448 + seg * 256 + lo) * 768);
    R.q0 = __builtin_amdgcn_raw_buffer_load_b128(C.rQ, C.vq, sq, 0); R.q1 = __builtin_amdgcn_raw_buffer_load_b128(C.rQ, C.vq + 16, sq, 0);
    R.k0 = __builtin_amdgcn_raw_buffer_load_b128(C.rQ, C.vq + 256, sq, 0); R.k1 = __builtin_amdgcn_raw_buffer_load_b128(C.rQ, C.vq + 272, sq, 0);
    R.vv = __builtin_amdgcn_raw_buffer_load_b64(C.rQ, C.vv, sq, 0);
    const unsigned st = (unsigned)((C.chain * 132 + ci) * 24576);
    R.t0 = __builtin_amdgcn_raw_buffer_load_b128(C.rT, C.vt, st, 0); R.w0 = __builtin_amdgcn_raw_buffer_load_b128(C.rT, C.vw, st, 0); R.w1 = __builtin_amdgcn_raw_buffer_load_b128(C.rT, C.vw + 16, st, 0);
    const unsigned sg = (unsigned)((C.chain * 132 + ci) * 512);
    R.bi = __builtin_bit_cast(float, __builtin_amdgcn_raw_buffer_load_b32(C.rG, C.vgb, sg, 0)); R.gi = __builtin_bit_cast(float, __builtin_amdgcn_raw_buffer_load_b32(C.rG, C.vgg, sg, 0));
}
__device__ __forceinline__ void gdn_chunk(const GdnCtx& C, GdnRegs& R, f32x4 (&Sacc)[2], int ci) {
    constexpr int PK = 272, PP = 144, PV = 80;
    const int lane = C.lane, w = C.w, fr = C.fr, fq = C.fq, li = C.li, seg8 = C.seg8, it = C.it, half = C.half;
    const int seg = ci < 4 ? 0 : 1, cs = seg == 0 ? ci : ci - 4, nch = seg == 0 ? 4 : 128, lo = (C.dir == 0 ? cs : nch - 1 - cs) * 64;
    if (w < 2) C.gcs[w * 64 + lane] = R.gi;
    {
        const int o = li * PK + seg8 * 32;
        *(LAS v4u*)(C.Qb + o) = R.q0; *(LAS v4u*)(C.Qb + o + 16) = R.q1;
        *(LAS v4u*)(C.Kb + o) = R.k0; *(LAS v4u*)(C.Kb + o + 16) = R.k1;
        *(LAS v4u*)(C.Wn + o) = R.w0; *(LAS v4u*)(C.Wn + o + 16) = R.w1;
        *(LAS v4u*)(C.Tm + li * PP + seg8 * 16) = R.t0;
        const float bti = R.bi;
        *(LAS v2u*)(C.VB + li * PV + seg8 * 8) = (v2u){pk2(bflo(R.vv.x) * bti, bfhi(R.vv.x) * bti), pk2(bflo(R.vv.y) * bti, bfhi(R.vv.y) * bti)};
    }
    LDS_BARRIER();
    gdn_load(C, R, ci + 2 < 132 ? ci + 2 : 131);
    f32x4 acc_o = (f32x4){0.f, 0.f, 0.f, 0.f}, acc_v = acc_o;
    {
        bf16x8 aq[4], kb[2][4], tm[2], vb[2], bs[4], wn[4];
        float gr[4], gj[2];
#pragma unroll
        for (int ks = 0; ks < 4; ++ks) aq[ks] = ld_row(C.Qb, PK, it * 16, ks * 32, lane);
#pragma unroll
        for (int jj = 0; jj < 2; ++jj)
#pragma unroll
            for (int ks = 0; ks < 4; ++ks) kb[jj][ks] = ld_row(C.Kb, PK, (2 * half + jj) * 16, ks * 32, lane);
#pragma unroll
        for (int ks = 0; ks < 2; ++ks) { tm[ks] = ld_row(C.Tm, PP, it * 16, ks * 32, lane); vb[ks] = ld_tr(C.VB, PV, ks * 32, half * 16, lane); }
#pragma unroll
        for (int ks = 0; ks < 4; ++ks) { bs[ks] = ld_row(C.St, PK, half * 16, ks * 32, lane); wn[ks] = ld_row(C.Wn, PK, it * 16, ks * 32, lane); }
#pragma unroll
        for (int r = 0; r < 4; ++r) gr[r] = C.gcs[it * 16 + 4 * fq + r];
        gj[0] = C.gcs[(2 * half) * 16 + fr]; gj[1] = C.gcs[(2 * half + 1) * 16 + fr];
        const float gl = C.gcs[63];
        __builtin_amdgcn_sched_barrier(0);
#pragma unroll
        for (int jj = 0; jj < 2; ++jj) {
            const int jt = 2 * half + jj;
            f32x4 accQ = (f32x4){0.f, 0.f, 0.f, 0.f};
            if (jt <= it) {
#pragma unroll
                for (int ks = 0; ks < 4; ++ks) accQ = MFMA16(aq[ks], kb[jj][ks], accQ);
            }
#pragma unroll
            for (int r = 0; r < 4; ++r) {
                const int il = 4 * fq + r;
                const bool lowereq = jt < it || (jt == it && il >= fr);
                const float qk = lowereq ? accQ[r] * __expf(gr[r] - gj[jj]) : 0.f;
                *(LAS unsigned short*)(C.QKd + (it * 16 + il) * PP + (jt * 16 + fr) * 2) = (unsigned short)f2bf(qk);
            }
        }
        const int nks = it >= 2 ? 2 : 1;
#pragma unroll
        for (int ks = 0; ks < 2; ++ks) if (ks < nks) acc_v = MFMA16(tm[ks], vb[ks], acc_v);
#pragma unroll
        for (int ks = 0; ks < 4; ++ks) { acc_v = MFMA16(wn[ks], bs[ks], acc_v); acc_o = MFMA16(aq[ks], bs[ks], acc_o); }
        float sv[4];
#pragma unroll
        for (int r = 0; r < 4; ++r) { acc_o[r] *= __expf(gr[r]); sv[r] = acc_v[r] * __expf(gl - gr[r]); }
        const int o = (half * 16 + fr) * PP + (it * 16 + 4 * fq) * 2;
        *(LAS v2u*)(C.Vt + o) = (v2u){pk2(acc_v[0], acc_v[1]), pk2(acc_v[2], acc_v[3])};
        *(LAS v2u*)(C.Vst + o) = (v2u){pk2(sv[0], sv[1]), pk2(sv[2], sv[3])};
    }
    LDS_BARRIER();
    {
        const int d0 = 16 * w;
        bf16x8 qd[2], vt[2], kt[2], vs[2][2];
#pragma unroll
        for (int ks = 0; ks < 2; ++ks) { qd[ks] = ld_row(C.QKd, PP, it * 16, ks * 32, lane); vt[ks] = ld_row(C.Vt, PP, half * 16, ks * 32, lane); kt[ks] = ld_tr(C.Kb, PK, ks * 32, d0, lane); }
#pragma unroll
        for (int ct = 0; ct < 2; ++ct)
#pragma unroll
            for (int ks = 0; ks < 2; ++ks) vs[ct][ks] = ld_row(C.Vst, PP, ct * 16, ks * 32, lane);
        const float egl = __expf(C.gcs[63]);
        __builtin_amdgcn_sched_barrier(0);
#pragma unroll
        for (int ks = 0; ks < 2; ++ks) if (2 * ks <= it) acc_o = MFMA16(qd[ks], vt[ks], acc_o);
        {
            const unsigned so = (unsigned)((((C.dir * 8 + C.h) * 4 + C.sl) * NLAT + C.b * SEQ + lo) * 64);
#pragma unroll
            for (int r = 0; r < 4; ++r) {
                const unsigned short ov = (unsigned short)f2bf(acc_o[r]);
                if (seg == 1) __builtin_amdgcn_raw_buffer_store_b16(ov, C.rO, C.dir == 0 ? C.vo + 64 * r : C.vo - 64 * r, so, 0);
                else __builtin_amdgcn_raw_buffer_store_b16(ov, C.rJ, C.vj + 2 * r, 0, 0); }
        }
#pragma unroll
        for (int ct = 0; ct < 2; ++ct) {
#pragma unroll
            for (int r = 0; r < 4; ++r) Sacc[ct][r] *= egl;
#pragma unroll
            for (int ks = 0; ks < 2; ++ks) Sacc[ct] = MFMA16(kt[ks], vs[ct][ks], Sacc[ct]);
            *(LAS v2u*)(C.St + (ct * 16 + fr) * PK + (d0 + 4 * fq) * 2) = (v2u){pk2(Sacc[ct][0], Sacc[ct][1]), pk2(Sacc[ct][2], Sacc[ct][3])};
        }
    }
    LDS_BARRIER();
}
__device__ __forceinline__ void p3_gdn_chunk(Frame& F, bf16* OA) {
    constexpr int PK = 272, PP = 144, PV = 80;
    GdnCtx C;
    C.Kb = F.lds; C.Qb = C.Kb + 64 * PK; C.Wn = C.Qb + 64 * PK; C.VB = C.Wn + 64 * PK; C.Tm = C.VB + 64 * PV; C.QKd = C.Tm + 64 * PP; C.St = C.QKd + 64 * PP;
    C.Vt = C.St + 32 * PK; C.Vst = C.Vt + 32 * PP; C.gcs = (LAS float*)(C.Vst + 32 * PP); C.bet = C.gcs + 64;
    C.QKVC = (const bf16*)(F.ws + WS_QKVC); C.GCB = (const float*)(F.ws + WS_GCB); C.TW = F.ws + WS_R1; C.OA = OA; C.JUNK = (bf16*)(F.ws + WS_AB) + (blockIdx.x * NT) * 8;
    C.lane = F.lane; C.w = F.wave; C.fr = F.lane & 15; C.fq = F.lane >> 4; C.li = F.tid >> 3; C.seg8 = F.tid & 7; C.it = F.wave >> 1; C.half = F.wave & 1;
    C.rQ = __builtin_amdgcn_make_buffer_rsrc((void*)C.QKVC, 0, 0x7fffffff, 0x00020000); C.rT = __builtin_amdgcn_make_buffer_rsrc((void*)C.TW, 0, 0x7fffffff, 0x00020000);
    C.rG = __builtin_amdgcn_make_buffer_rsrc((void*)C.GCB, 0, 0x7fffffff, 0x00020000); C.rO = __builtin_amdgcn_make_buffer_rsrc((void*)C.OA, 0, 0x7fffffff, 0x00020000);
    C.rJ = __builtin_amdgcn_make_buffer_rsrc((void*)C.JUNK, 0, 0x7fffffff, 0x00020000);
    C.vt = (unsigned)(C.li * 128 + C.seg8 * 16); C.vw = (unsigned)(8192 + C.li * 256 + C.seg8 * 32); C.vgb = (unsigned)((64 + C.li) * 4); C.vgg = (unsigned)(((C.w & 1) * 64 + C.lane) * 4);
    C.vj = (unsigned)(F.tid * 16);
    for (int item = blockIdx.x; item < 256; item += F.G) {
        const int xcd = item & 7, idx = item >> 3;
        C.chain = xcd * 8 + (idx >> 2); C.sl = idx & 3; C.b = C.chain >> 4; C.h = (C.chain >> 1) & 7; C.dir = C.chain & 1;
        { const int rl = C.dir == 0 ? C.li : 63 - C.li; C.vq = (unsigned)(rl * 768 + C.seg8 * 32); C.vv = (unsigned)(rl * 768 + 512 + C.sl * 64 + C.seg8 * 8);
          const int i0 = C.it * 16 + 4 * C.fq; C.vo = (unsigned)(((C.dir == 0 ? i0 : 63 - i0) * 32 + C.half * 16 + C.fr) * 2); }
        f32x4 Sacc[2]; Sacc[0] = (f32x4){0.f, 0.f, 0.f, 0.f}; Sacc[1] = Sacc[0];
        __syncthreads();
        for (int i = F.tid; i < 32 * PK / 4; i += NT) ((LAS unsigned*)C.St)[i] = 0u;
        GdnRegs R0, R1;
        R0.gi = R0.bi = R1.gi = R1.bi = 0.f;
        gdn_load(C, R0, 0); gdn_load(C, R1, 1);
        for (int ci = 0; ci < 132; ci += 2) { gdn_chunk(C, R0, Sacc, ci); gdn_chunk(C, R1, Sacc, ci + 1); }
    }
}
typedef float f32x2v __attribute__((ext_vector_type(2)));
#define F2V(a, b) ((f32x2v){(a), (b)})
template <bool B> struct HgTag { static constexpr bool value = B; };
constexpr int HG_SPLIT = 76;
__device__ __forceinline__ void p5_hg_chunk(Frame& F, bf16* OB) {
    constexpr int PK = 272, PP = 144;
    LAS unsigned char* Qd = F.lds;
    LAS unsigned char* Kinv = Qd + 64 * PK;
    LAS unsigned char* Vv = Kinv + 64 * PK;
    LAS unsigned char* St = Vv + 64 * PP;
    LAS unsigned char* Pm = St + 64 * PK;
    LAS float* totd = (LAS float*)(Pm + 64 * PP);
    LAS float* tot8 = totd + 128;
    LAS float* tot8b = tot8 + 1024;
    LAS float* totdb = tot8b + 1024;
    const bf16* QFI = (const bf16*)(F.ws + WS_R1);
    bf16* JUNK = (bf16*)(F.ws + WS_AB);
    const int tid = F.tid, lane = F.lane, w = F.wave, fr = lane & 15, fq = lane >> 4;
    const int dp = lane, rg = w;
    const int vr = tid >> 3, vs = (tid & 7) * 8;
    const int it = w >> 1, half = w & 1;
    for (int item = blockIdx.x; item < 256; item += F.G) {
        const int part = item >> 7, base = item & 127;
        const int xcd = base & 7, idx = base >> 3, chain = xcd * 8 + (idx >> 1), sl = idx & 1;
        const int b = chain >> 4, h = (chain >> 1) & 7, dir = chain & 1;
        f32x4 Sacc[4];
#pragma unroll
        for (int ct = 0; ct < 4; ++ct) Sacc[ct] = (f32x4){0.f, 0.f, 0.f, 0.f};
        __syncthreads();
        for (int i = tid; i < 64 * PK / 4; i += NT) ((LAS unsigned*)St)[i] = 0u;
        unsigned qA[8], fA[8], qB[8], fB[8]; v4u vA, vB;
#define HG_LOAD(ci) do { \
            const int seg_ = (ci) < 4 ? 0 : 1, cs_ = seg_ == 0 ? (ci) : (ci) - 4, nch_ = seg_ == 0 ? 4 : 128, lo_ = (dir == 0 ? cs_ : nch_ - 1 - cs_) * 64 + seg_ * 256; \
            const bf16* cb_ = QFI + ((size_t)(b * 8 + h) * 8448 + lo_) * 512;     \
            _Pragma("unroll") for (int il = 0; il < 8; ++il) { const int i_ = rg * 8 + il; const bf16* rp_ = cb_ + (dir == 0 ? i_ : 63 - i_) * 512 + 2 * dp; \
                qraw[il] = *(const unsigned*)rp_; fraw[il] = *(const unsigned*)(rp_ + 128 + dir * 128); } \
            vraw = *(const v4u*)(cb_ + (dir == 0 ? vr : 63 - vr) * 512 + 384 + sl * 64 + vs); } while (0)
        auto chunk = [&](auto tag, const int ci, unsigned (&qraw)[8], unsigned (&fraw)[8], v4u& vraw) __attribute__((always_inline)) {
            constexpr bool FULL = decltype(tag)::value;
            const int seg = ci < 4 ? 0 : 1, cs = seg == 0 ? ci : ci - 4, nch = seg == 0 ? 4 : 128, lo = (dir == 0 ? cs : nch - 1 - cs) * 64;
            float f0[8], f1[8], p0[8], p1[8]; float r0 = 1.f, r1 = 1.f;
#pragma unroll
            for (int il = 0; il < 8; ++il) { f0[il] = __builtin_amdgcn_exp2f(bflo(fraw[il])); f1[il] = __builtin_amdgcn_exp2f(bfhi(fraw[il])); r0 *= f0[il]; r1 *= f1[il]; p0[il] = r0; p1[il] = r1; }
            *(LAS f32x2v*)(tot8 + rg * 128 + 2 * dp) = F2V(r0, r1);
            *(LAS v4u*)(Vv + vr * PP + vs * 2) = vraw;
            LDS_BARRIER();
            {
                float o0 = 1.f, o1 = 1.f, a0 = 1.f, a1 = 1.f;
#pragma unroll
                for (int g = 0; g < 8; ++g) { const f32x2v t = *(const LAS f32x2v*)(tot8 + g * 128 + 2 * dp); if (g < rg) { o0 *= t.x; o1 *= t.y; } a0 *= t.x; a1 *= t.y; }
                if (rg == 0) *(LAS f32x2v*)(totd + 2 * dp) = F2V(a0, a1);
                float n0 = __builtin_amdgcn_rcpf(p0[7] * o0), n1 = __builtin_amdgcn_rcpf(p1[7] * o1);
#pragma unroll
                for (int il = 7; il >= 0; --il) {
                    const float e0 = p0[il] * o0, e1 = p1[il] * o1;
                    const int o = (rg * 8 + il) * PK + dp * 4;
                    if constexpr (FULL) *(LAS unsigned*)(Qd + o) = pk2(bflo(qraw[il]) * e0, bfhi(qraw[il]) * e1);
                    *(LAS unsigned*)(Kinv + o) = pk2((1.f - f0[il]) * n0, (1.f - f1[il]) * n1);
                    n0 *= f0[il]; n1 *= f1[il];
                }
            }
            LDS_BARRIER();
            HG_LOAD(ci + 2 < 132 ? ci + 2 : 131);
            f32x4 acc_o[2];
            if constexpr (FULL) {
                bf16x8 aq[4], bs[2][4], bk[2][4];
#pragma unroll
                for (int ks = 0; ks < 4; ++ks) aq[ks] = ld_row(Qd, PK, it * 16, ks * 32, lane);
#pragma unroll
                for (int cc = 0; cc < 2; ++cc)
#pragma unroll
                    for (int ks = 0; ks < 4; ++ks) bs[cc][ks] = ld_row(St, PK, (2 * half + cc) * 16, ks * 32, lane);
                __builtin_amdgcn_sched_barrier(0);
#pragma unroll
                for (int jj = 0; jj < 2; ++jj)
#pragma unroll
                    for (int ks = 0; ks < 4; ++ks) bk[jj][ks] = ld_row(Kinv, PK, (2 * half + jj) * 16, ks * 32, lane);
#pragma unroll
                for (int cc = 0; cc < 2; ++cc) { acc_o[cc] = (f32x4){0.f, 0.f, 0.f, 0.f};
#pragma unroll
                    for (int ks = 0; ks < 4; ++ks) acc_o[cc] = MFMA16(aq[ks], bs[cc][ks], acc_o[cc]); }
                __builtin_amdgcn_sched_barrier(0);
#pragma unroll
                for (int jj = 0; jj < 2; ++jj) {
                    const int jt = 2 * half + jj;
                    f32x4 acc_s = (f32x4){0.f, 0.f, 0.f, 0.f};
                    if (jt <= it) {
#pragma unroll
                        for (int ks = 0; ks < 4; ++ks) acc_s = MFMA16(aq[ks], bk[jj][ks], acc_s);
                    }
#pragma unroll
                    for (int r = 0; r < 4; ++r) {
                        float v = acc_s[r];
                        if (jt == it && (4 * fq + r) < fr) v = 0.f;
                        *(LAS unsigned short*)(Pm + (it * 16 + 4 * fq + r) * PP + (jt * 16 + fr) * 2) = (unsigned short)f2bf(v);
                    }
                }
                LDS_BARRIER();
            }
            {
                const int nks = it >= 2 ? 2 : 1, d0 = 16 * w;
                bf16x8 ap[2], bv[2][2], ak[2], vv[4][2]; float td[4];
                if constexpr (FULL) {
                    ap[0] = ld_row(Pm, PP, it * 16, 0, lane); ap[1] = ld_row(Pm, PP, it * 16, 32, lane);
#pragma unroll
                    for (int cc = 0; cc < 2; ++cc)
#pragma unroll
                        for (int ks = 0; ks < 2; ++ks) bv[cc][ks] = ld_tr(Vv, PP, ks * 32, (2 * half + cc) * 16, lane);
                }
                ak[0] = ld_tr(Kinv, PK, 0, d0, lane); ak[1] = ld_tr(Kinv, PK, 32, d0, lane);
#pragma unroll
                for (int ct = 0; ct < 4; ++ct)
#pragma unroll
                    for (int ks = 0; ks < 2; ++ks) vv[ct][ks] = ld_tr(Vv, PP, ks * 32, ct * 16, lane);
#pragma unroll
                for (int r = 0; r < 4; ++r) td[r] = totd[d0 + 4 * fq + r];
                __builtin_amdgcn_sched_barrier(0);
                if constexpr (FULL) {
#pragma unroll
                for (int cc = 0; cc < 2; ++cc) {
#pragma unroll
                    for (int ks = 0; ks < 2; ++ks) if (ks < nks) acc_o[cc] = MFMA16(ap[ks], bv[cc][ks], acc_o[cc]);
                }
                {
#pragma unroll
                    for (int r = 0; r < 4; ++r) { const int i = it * 16 + 4 * fq + r, p = dir == 0 ? lo + i : lo + 63 - i;
                        bf16* op = seg == 1 ? OB + ((((size_t)dir * 4 + b) * 8 + h) * SEQ + p) * 128 + sl * 64 + 32 * half + fr
                                            : JUNK + ((blockIdx.x & 127) * NT + tid) * 32 + r;
                        op[0] = (bf16)f2bf(acc_o[0][r]); op[16] = (bf16)f2bf(acc_o[1][r]); }
                }
                }
#pragma unroll
                for (int ct = 0; ct < 4; ++ct) {
                    f32x4 acc = Sacc[ct];
#pragma unroll
                    for (int ks = 0; ks < 2; ++ks) acc = MFMA16(ak[ks], vv[ct][ks], acc);
#pragma unroll
                    for (int r = 0; r < 4; ++r) Sacc[ct][r] = acc[r] * td[r];
                    *(LAS v2u*)(St + (ct * 16 + fr) * PK + (d0 + 4 * fq) * 2) = (v2u){pk2(Sacc[ct][0], Sacc[ct][1]), pk2(Sacc[ct][2], Sacc[ct][3])};
                }
            }
            LDS_BARRIER();
        };
        auto state2 = [&](const int ci, unsigned (&q1)[8], unsigned (&f1r)[8], v4u& v1, unsigned (&q2)[8], unsigned (&f2r)[8], v4u& v2) __attribute__((always_inline)) {
            LAS unsigned char* KinvB = Qd; LAS unsigned char* VvB = Pm;
            float fa0[8], fa1[8], fb0[8], fb1[8], ea0, ea1, eb0, eb1;
            {
                float r0 = 1.f, r1 = 1.f;
#pragma unroll
                for (int il = 0; il < 8; ++il) { fa0[il] = __builtin_amdgcn_exp2f(bflo(f1r[il])); fa1[il] = __builtin_amdgcn_exp2f(bfhi(f1r[il])); r0 *= fa0[il]; r1 *= fa1[il]; }
                ea0 = r0; ea1 = r1;
                *(LAS f32x2v*)(tot8 + rg * 128 + 2 * dp) = F2V(r0, r1);
                *(LAS v4u*)(Vv + vr * PP + vs * 2) = v1;
                r0 = 1.f; r1 = 1.f;
#pragma unroll
                for (int il = 0; il < 8; ++il) { fb0[il] = __builtin_amdgcn_exp2f(bflo(f2r[il])); fb1[il] = __builtin_amdgcn_exp2f(bfhi(f2r[il])); r0 *= fb0[il]; r1 *= fb1[il]; }
                eb0 = r0; eb1 = r1;
                *(LAS f32x2v*)(tot8b + rg * 128 + 2 * dp) = F2V(r0, r1);
                *(LAS v4u*)(VvB + vr * PP + vs * 2) = v2;
            }
            LDS_BARRIER();
#define HG_KINV(T8, TD, KI, F0, F1, E0, E1) do { float o0 = 1.f, o1 = 1.f, a0 = 1.f, a1 = 1.f; \
                _Pragma("unroll") for (int g = 0; g < 8; ++g) { const f32x2v t = *(const LAS f32x2v*)(T8 + g * 128 + 2 * dp); if (g < rg) { o0 *= t.x; o1 *= t.y; } a0 *= t.x; a1 *= t.y; } \
                if (rg == 0) *(LAS f32x2v*)(TD + 2 * dp) = F2V(a0, a1); \
                float n0 = __builtin_amdgcn_rcpf(E0 * o0), n1 = __builtin_amdgcn_rcpf(E1 * o1); \
                _Pragma("unroll") for (int il = 7; il >= 0; --il) { *(LAS unsigned*)(KI + (rg * 8 + il) * PK + dp * 4) = pk2((1.f - F0[il]) * n0, (1.f - F1[il]) * n1); n0 *= F0[il]; n1 *= F1[il]; } } while (0)
            HG_KINV(tot8, totd, Kinv, fa0, fa1, ea0, ea1);
            HG_KINV(tot8b, totdb, KinvB, fb0, fb1, eb0, eb1);
#undef HG_KINV
            LDS_BARRIER();
            { const int c1 = ci + 4 < 132 ? ci + 4 : 131, c2 = ci + 5 < 132 ? ci + 5 : 131;
              { unsigned (&qraw)[8] = q1; unsigned (&fraw)[8] = f1r; v4u& vraw = v1; HG_LOAD(c1); }
              { unsigned (&qraw)[8] = q2; unsigned (&fraw)[8] = f2r; v4u& vraw = v2; HG_LOAD(c2); } }
            {
                const int d0 = 16 * w;
                bf16x8 ak[2], vv[4][2]; float td[4];
#pragma unroll
                for (int cc = 0; cc < 2; ++cc) {
                    LAS unsigned char* KI = cc == 0 ? Kinv : KinvB; LAS unsigned char* VI = cc == 0 ? Vv : VvB; LAS float* TD = cc == 0 ? totd : totdb;
                    ak[0] = ld_tr(KI, PK, 0, d0, lane); ak[1] = ld_tr(KI, PK, 32, d0, lane);
#pragma unroll
                    for (int ct = 0; ct < 4; ++ct)
#pragma unroll
                        for (int ks = 0; ks < 2; ++ks) vv[ct][ks] = ld_tr(VI, PP, ks * 32, ct * 16, lane);
#pragma unroll
                    for (int r = 0; r < 4; ++r) td[r] = TD[d0 + 4 * fq + r];
                    __builtin_amdgcn_sched_barrier(0);
#pragma unroll
                    for (int ct = 0; ct < 4; ++ct) {
                        f32x4 acc = Sacc[ct];
#pragma unroll
                        for (int ks = 0; ks < 2; ++ks) acc = MFMA16(ak[ks], vv[ct][ks], acc);
#pragma unroll
                        for (int r = 0; r < 4; ++r) Sacc[ct][r] = acc[r] * td[r];
                        if (cc == 1) *(LAS v2u*)(St + (ct * 16 + fr) * PK + (d0 + 4 * fq) * 2) = (v2u){pk2(Sacc[ct][0], Sacc[ct][1]), pk2(Sacc[ct][2], Sacc[ct][3])};
                    }
                    __builtin_amdgcn_sched_barrier(0);
                }
            }
            LDS_BARRIER();
        };
        { unsigned (&qraw)[8] = qA; unsigned (&fraw)[8] = fA; v4u& vraw = vA; HG_LOAD(0); }
        { unsigned (&qraw)[8] = qB; unsigned (&fraw)[8] = fB; v4u& vraw = vB; HG_LOAD(1); }
        if (part == 0) {
            for (int ci = 0; ci < HG_SPLIT; ci += 2) { chunk(HgTag<true>{}, ci, qA, fA, vA); chunk(HgTag<true>{}, ci + 1, qB, fB, vB); }
        } else {
            unsigned qC[8], fC[8], qD[8], fD[8]; v4u vC, vD;
            { unsigned (&qraw)[8] = qC; unsigned (&fraw)[8] = fC; v4u& vraw = vC; HG_LOAD(2); }
            { unsigned (&qraw)[8] = qD; unsigned (&fraw)[8] = fD; v4u& vraw = vD; HG_LOAD(3); }
            for (int ci = 0; ci < HG_SPLIT; ci += 4) { state2(ci, qA, fA, vA, qB, fB, vB); state2(ci + 2, qC, fC, vC, qD, fD, vD); }
            for (int ci = HG_SPLIT; ci < 132; ci += 2) { chunk(HgTag<true>{}, ci, qA, fA, vA); chunk(HgTag<true>{}, ci + 1, qB, fB, vB); }
        }
#undef HG_LOAD
    }
}
typedef unsigned v6u __attribute__((ext_vector_type(6)));
typedef unsigned v3u __attribute__((ext_vector_type(3)));
typedef v3u v3u_a4 __attribute__((aligned(4)));
typedef v4u v4u_a8 __attribute__((aligned(8)));
typedef float v32f __attribute__((ext_vector_type(32)));
typedef __bf16 v32bf __attribute__((ext_vector_type(32)));
__device__ __forceinline__ void side_work(Frame& F, int sid, int nside) {
    const float* w_in = late_arg(7); const float* w_pa = late_arg(14); const float* w_pb = late_arg(15); const float* w_o = late_arg(16); const float* w_query = late_arg(18);
    const float* sub_keys = late_arg(19); const float* expert_u = late_arg(20); const float* expert_v = late_arg(21);
    const int gw = sid * NWAVES + F.wave, NGW = nside * NWAVES;
    {
        LAS float* scr = (LAS float*)(F.lds + 49152 + F.wave * 8448);
        bf16* WTC = (bf16*)(F.ws + WS_WTC);
        constexpr int J3 = 16 * 32, J4 = 16 * 32, J5 = 16 * 64, J6 = 16 * 32, J7 = 16 * 32, J8 = 16 * 32, J9 = 16 * 64;
        for (int it = gw; it < J3 + J4 + J5 + J6 + J7 + J8 + J9; it += NGW) {
            int r = it;
        if (r < J3) { p0_transpose_item(w_in + C_GA, NIN, 1024, D, WTC, scr, r, F.lane); continue; } r -= J3;
        if (r < J4) { p0_transpose_item(w_in + C_GB, NIN, 1024, D, WTC + (size_t)1024 * D, scr, r, F.lane); continue; } r -= J4;
        if (r < J5) {
            const int c0 = 32 * (r % 64), nr0 = ((c0 & 1023) >> 7) * 256 + (c0 >> 10) * 128 + (c0 & 127);
            p0_transpose_item(w_in + C_MG, NIN, 2048, D, WTC + ((size_t)2048 + nr0) * D - (size_t)c0 * D, scr, r, F.lane); continue; } r -= J5;
        if (r < J6) { p0_transpose_item(w_pa, 1024, 1024, D, (bf16*)(F.ws + WS_WTPA), scr, r, F.lane, 2048); continue; } r -= J6;
        if (r < J7) { p0_transpose_item(w_pb, 1024, 1024, D, (bf16*)(F.ws + WS_WTPA) + 1024, scr, r, F.lane, 2048); continue; } r -= J7;
        if (r < J8) { p0_transpose_item(w_o, 1024, 1024, D, (bf16*)(F.ws + WS_WTO), scr, r, F.lane); continue; } r -= J8;
        p0_transpose_item(w_query, 2048, 2048, D, (bf16*)(F.ws + WS_WTQ), scr, r, F.lane);
        }
    }
    { const f32x4* sk = (const f32x4*)sub_keys; v2u* o = (v2u*)(F.ws + WS_SKB);
      for (int i = sid * NT + F.tid; i < 65536; i += nside * NT) { const f32x4 v = sk[i]; o[i] = (v2u){pk2(v.x, v.y), pk2(v.z, v.w)}; } }
    for (int row0 = 2 * gw; row0 < 2 * 16384; row0 += 2 * NGW) {
        f32x4 v[2][4]; float am[2];
#pragma unroll
        for (int k = 0; k < 2; ++k) { const int row = row0 + k, tb = row >> 14, r = row & 16383;
            const f32x4* sp = (const f32x4*)((tb == 0 ? expert_u : expert_v) + (size_t)r * D + 16 * F.lane);
#pragma unroll
            for (int q = 0; q < 4; ++q) v[k][q] = sp[q]; }
#pragma unroll
        for (int k = 0; k < 2; ++k) { float a = 0.f;
#pragma unroll
            for (int q = 0; q < 4; ++q) a = fmaxf(a, fmaxf(fmaxf(fabsf(v[k][q].x), fabsf(v[k][q].y)), fmaxf(fabsf(v[k][q].z), fabsf(v[k][q].w))));
            am[k] = a; }
#pragma unroll
        for (int o = 1; o < 64; o <<= 1) { am[0] = fmaxf(am[0], __shfl_xor(am[0], o)); am[1] = fmaxf(am[1], __shfl_xor(am[1], o)); }
#pragma unroll
        for (int k = 0; k < 2; ++k) { const int row = row0 + k, tb = row >> 14, r = row & 16383;
            const float scale = am[k] > 0.f ? am[k] * (1.f / 7.5f) : 1.f, inv = 1.f / scale;
            unsigned c[16];
#pragma unroll
            for (int q = 0; q < 4; ++q) {
#pragma unroll
                for (int i = 0; i < 4; ++i) {
                    const float x = v[k][q][i] * inv, a = fminf(fabsf(x), 7.5f);
                    int e = (int)(__builtin_bit_cast(unsigned, a) >> 23) - 127; e = e < 0 ? 0 : e;
                    const float m8 = __builtin_rintf(a * __builtin_bit_cast(float, (unsigned)(130 - e) << 23));
                    c[4 * q + i] = ((unsigned)(int)m8 + 8u * (unsigned)e) | (x < 0.f ? 32u : 0u); }
            }
            unsigned long long lo = 0ull;
#pragma unroll
            for (int i = 0; i < 10; ++i) lo |= (unsigned long long)c[i] << (6 * i);
            lo |= (unsigned long long)c[10] << 60;
            const unsigned d2 = (c[10] >> 4) | (c[11] << 2) | (c[12] << 8) | (c[13] << 14) | (c[14] << 20) | (c[15] << 26);
            *(v3u_a4*)(F.ws + (tb == 0 ? ws_eux(F.lane >> 3) + (size_t)r * 128 + 32 * ((F.lane & 7) >> 1) + 12 * (F.lane & 1)
                                      : WS_EV6 + (size_t)r * 768 + 12 * F.lane)) = (v3u){(unsigned)lo, (unsigned)(lo >> 32), d2};
            if (F.lane == 0) ((float*)(F.ws + WS_ESC))[row] = scale; }
    }
}

__device__ __forceinline__ void p10_h2(Frame& F) {
    const float* norm2_w = late_arg(17);
    const int gw = blockIdx.x * NWAVES + F.wave, NGW = F.G * NWAVES;
    const float* MOD = (const float*)(F.ws + WS_MOD); const bf16* X1 = (const bf16*)(F.ws + WS_R1); bf16* H2 = (bf16*)(F.ws + WS_H);
    {
        const float* sub_keys = late_arg(19); const bf16* WTQ = (const bf16*)(F.ws + WS_WTQ); bf16* WTF = (bf16*)(F.ws + WS_WTF);
        for (int row = gw; row < 2048; row += NGW) {
            const bf16* wq = WTQ + (size_t)(row >> 7) * 128 * D + 16 * F.lane; const float* sk = sub_keys + (size_t)row * 128;
            float a[16];
#pragma unroll
            for (int j = 0; j < 16; ++j) a[j] = 0.f;
#pragma unroll 4
            for (int d = 0; d < 128; ++d) { const float sv = sk[d]; const v4u w0 = *(const v4u*)(wq + (size_t)d * D), w1 = *(const v4u*)(wq + (size_t)d * D + 8);
#pragma unroll
                for (int e = 0; e < 4; ++e) { a[2 * e] = fmaf(sv, bflo(w0[e]), a[2 * e]); a[2 * e + 1] = fmaf(sv, bfhi(w0[e]), a[2 * e + 1]); a[8 + 2 * e] = fmaf(sv, bflo(w1[e]), a[8 + 2 * e]); a[9 + 2 * e] = fmaf(sv, bfhi(w1[e]), a[9 + 2 * e]); } }
            *(v4u*)(WTF + (size_t)row * D + 16 * F.lane) = (v4u){pk2(a[0], a[1]), pk2(a[2], a[3]), pk2(a[4], a[5]), pk2(a[6], a[7])};
            *(v4u*)(WTF + (size_t)row * D + 16 * F.lane + 8) = (v4u){pk2(a[8], a[9]), pk2(a[10], a[11]), pk2(a[12], a[13]), pk2(a[14], a[15])};
        }
    }
    for (int r0 = 2 * gw; r0 < NLAT; r0 += 2 * NGW) {
        v4u raw[2][2]; float ss[2];
#pragma unroll
        for (int k = 0; k < 2; ++k)
#pragma unroll
            for (int j = 0; j < 2; ++j) raw[k][j] = *(const v4u*)(X1 + (size_t)(r0 + k) * D + 512 * j + 8 * F.lane);
#pragma unroll
        for (int k = 0; k < 2; ++k) { float sq = 0.f;
#pragma unroll
            for (int j = 0; j < 2; ++j)
#pragma unroll
                for (int e = 0; e < 4; ++e) { const float a = bflo(raw[k][j][e]), b = bfhi(raw[k][j][e]); sq += a * a + b * b; }
            ss[k] = sq; }
#pragma unroll
        for (int o = 1; o < 64; o <<= 1) { ss[0] += __shfl_xor(ss[0], o); ss[1] += __shfl_xor(ss[1], o); }
        const float* md = MOD + (size_t)(r0 >> 13) * 6144;
#pragma unroll
        for (int j = 0; j < 2; ++j) { const int c0 = 512 * j + 8 * F.lane;
            const f32x4 w0 = *(const f32x4*)(norm2_w + c0), w1 = *(const f32x4*)(norm2_w + c0 + 4), h0 = *(const f32x4*)(md + 3072 + c0), h1 = *(const f32x4*)(md + 3072 + c0 + 4),
                        s0 = *(const f32x4*)(md + 4096 + c0), s1 = *(const f32x4*)(md + 4096 + c0 + 4);
#pragma unroll
            for (int k = 0; k < 2; ++k) { const float r = rsqrtf(ss[k] * (1.f / D) + EPS);
                const f32x4 x0 = (f32x4){bflo(raw[k][j].x), bfhi(raw[k][j].x), bflo(raw[k][j].y), bfhi(raw[k][j].y)}, x1 = (f32x4){bflo(raw[k][j].z), bfhi(raw[k][j].z), bflo(raw[k][j].w), bfhi(raw[k][j].w)};
                const f32x4 y0 = x0 * r * w0 * (s0 + 1.f) + h0, y1 = x1 * r * w1 * (s1 + 1.f) + h1;
                *(v4u*)(H2 + (size_t)(r0 + k) * D + c0) = (v4u){pk2(y0.x, y0.y), pk2(y0.z, y0.w), pk2(y1.x, y1.y), pk2(y1.z, y1.w)}; } }
    }
}

__device__ __forceinline__ void ins16(unsigned (&top)[16], unsigned x) {
#pragma unroll
    for (int k = 0; k < 16; ++k) { const unsigned hi = top[k] > x ? top[k] : x; x = top[k] > x ? x : top[k]; top[k] = hi; }
}
#define CAS_DESC(a, b) do { const unsigned hi_ = (a) > (b) ? (a) : (b), lo_ = (a) > (b) ? (b) : (a); (a) = hi_; (b) = lo_; } while (0)
__device__ __forceinline__ void bitonic_sort16_desc(unsigned (&v)[16]) {
#pragma unroll
    for (int k = 2; k <= 16; k <<= 1)
#pragma unroll
        for (int j = k >> 1; j > 0; j >>= 1)
#pragma unroll
            for (int i = 0; i < 16; ++i) { const int l = i ^ j; if (l > i) { if ((i & k) == 0) CAS_DESC(v[i], v[l]); else CAS_DESC(v[l], v[i]); } }
}
__device__ __forceinline__ void bitonic_merge16_desc(unsigned (&v)[16]) {
#pragma unroll
    for (int j = 8; j > 0; j >>= 1)
#pragma unroll
        for (int i = 0; i < 16; ++i) { const int l = i ^ j; if (l > i) CAS_DESC(v[i], v[l]); }
}
__device__ __forceinline__ float ord16_to_float(unsigned o) {
    const unsigned hb = (o & 0x8000u) ? (o ^ 0x8000u) : (~o & 0xffffu);
    return (float)__builtin_bit_cast(_Float16, (unsigned short)hb);
}
__device__ __forceinline__ void p12_topk(Frame& F) {
    const unsigned short* SCG = (const unsigned short*)(F.ws + WS_R1 + 128 * MiB);
    int* EIDX = (int*)(F.ws + WS_OB + 64 * MiB); float* EG = (float*)(F.ws + WS_OB + 80 * MiB);
    const int lane = F.lane, h = F.wave, tok = 16 * (lane & 3) + (lane >> 2);
    LAS unsigned char* PAY = (LAS unsigned char*)(F.lds + h * 16384);
    for (int item = blockIdx.x; item < NLAT / 64; item += F.G) {
        const int t0 = item * 64;
        unsigned top[2][16];
#pragma unroll
        for (int c = 0; c < 2; ++c) {
#pragma unroll
            for (int k = 0; k < 16; ++k) top[c][k] = 0u;
            const unsigned short* sp = SCG + ((size_t)(item * 8 + h) * 2 + c) * 8192 + lane;
            unsigned short raw[16], nxt[16];
#pragma unroll
            for (int k = 0; k < 16; ++k) raw[k] = sp[k * 64];
#pragma unroll 1
            for (int g = 0; g < 8; ++g) {
                const int gn = g < 7 ? g + 1 : 7;
#pragma unroll
                for (int k = 0; k < 16; ++k) nxt[k] = sp[(gn * 16 + k) * 64];
                unsigned grp[16];
#pragma unroll
                for (int k = 0; k < 16; ++k) { const int key = g * 16 + k; const unsigned hb = raw[k];
                    const unsigned o = (hb & 0x8000u) ? (~hb & 0xffffu) : (hb | 0x8000u); grp[k] = (o << 16) | (unsigned)(127 - key); }
                bitonic_sort16_desc(grp);
#pragma unroll
                for (int k = 0; k < 16; ++k) top[c][k] = top[c][k] > grp[15 - k] ? top[c][k] : grp[15 - k];
                bitonic_merge16_desc(top[c]);
#pragma unroll
                for (int k = 0; k < 16; ++k) raw[k] = nxt[k];
            }
        }
        float f1[16], f2[16];
#pragma unroll
        for (int k = 0; k < 16; ++k) { f1[k] = ord16_to_float(top[0][k] >> 16); f2[k] = ord16_to_float(top[1][k] >> 16);
            PAY[k * 64 + lane] = (unsigned char)(127u - (top[0][k] & 127u)); PAY[(16 + k) * 64 + lane] = (unsigned char)(127u - (top[1][k] & 127u)); }
        unsigned best[16];
#pragma unroll
        for (int k = 0; k < 16; ++k) best[k] = 0u;
#pragma unroll
        for (int i = 0; i < 16; ++i)
#pragma unroll
            for (int j = 0; j < 16; ++j)
                if ((i + 1) * (j + 1) <= 16) {
                    const unsigned bits = __builtin_bit_cast(unsigned, f1[i] + f2[j]);
                    const unsigned u = bits ^ ((bits & 0x80000000u) ? 0xffffffffu : 0x80000000u);
                    ins16(best, (u & 0xffffff00u) | (unsigned)(255 - (i * 16 + j)));
                }
        float val[16], esum = 0.f;
#pragma unroll
        for (int k = 0; k < 16; ++k) { const unsigned u = best[k] & 0xffffff00u; val[k] = __builtin_bit_cast(float, (u & 0x80000000u) ? (u ^ 0x80000000u) : ~u); }
        const float vmax = val[0];
#pragma unroll
        for (int k = 0; k < 16; ++k) { val[k] = __expf(val[k] - vmax); esum += val[k]; }
        const float rs = 1.f / esum;
        asm volatile("s_waitcnt lgkmcnt(0)" ::: "memory");
        int eidx[16];
#pragma unroll
        for (int k = 0; k < 16; ++k) { const unsigned flat = 255u - (best[k] & 255u); const unsigned i = flat >> 4, j = flat & 15u;
            eidx[k] = (int)PAY[i * 64 + lane] * 128 + (int)PAY[(16 + j) * 64 + lane]; }
        {
            LAS unsigned char* TE = PAY + 4096; LAS unsigned char* TG = TE + 64 * 80;
#pragma unroll
            for (int q = 0; q < 4; ++q) {
                *(LAS v4u*)(TE + lane * 80 + q * 16) = (v4u){(unsigned)eidx[4 * q], (unsigned)eidx[4 * q + 1], (unsigned)eidx[4 * q + 2], (unsigned)eidx[4 * q + 3]};
                *(LAS f32x4*)(TG + lane * 80 + q * 16) = (f32x4){val[4 * q] * rs, val[4 * q + 1] * rs, val[4 * q + 2] * rs, val[4 * q + 3] * rs}; }
            asm volatile("s_waitcnt lgkmcnt(0)" ::: "memory");
#pragma unroll
            for (int k = 0; k < 4; ++k) {
                const int pl = (lane >> 2) + 16 * k, q = lane & 3, tk = 16 * (pl & 3) + (pl >> 2);
                const size_t ob = ((size_t)(t0 + tk) * 8 + h) * 16 + 4 * q;
                *(v4u*)(EIDX + ob) = *(const LAS v4u*)(TE + pl * 80 + q * 16);
                *(f32x4*)(EG + ob) = *(const LAS f32x4*)(TG + pl * 80 + q * 16);
            }
        }
    }
}

typedef __bf16 bf2_t __attribute__((ext_vector_type(2)));
__device__ __forceinline__ float dot2bf(unsigned a, unsigned b, float c) { return __builtin_amdgcn_fdot2_f32_bf16(__builtin_bit_cast(bf2_t, a), __builtin_bit_cast(bf2_t, b), c, false); }
template <int CTRL, int RMASK> __device__ __forceinline__ float dpp_get(float x) { return __builtin_bit_cast(float, __builtin_amdgcn_update_dpp(0, __builtin_bit_cast(int, x), CTRL, RMASK, 0xF, false)); }
__device__ __forceinline__ float wave_sum_uniform(float s) {
    s += dpp_get<0xB1, 0xF>(s); s += dpp_get<0x4E, 0xF>(s); s += dpp_get<0x124, 0xF>(s); s += dpp_get<0x128, 0xF>(s);
    s += dpp_get<0x142, 0xA>(s); s += dpp_get<0x143, 0xC>(s);
    return __builtin_bit_cast(float, __builtin_amdgcn_readlane(__builtin_bit_cast(int, s), 63));
}
__device__ __forceinline__ float gelu_erf(float v) {
    const float av = fabsf(v), t = __builtin_amdgcn_rcpf(fmaf(av, 0.2316418882f, 1.0f));
    float q = fmaf(t, 0.5307027145f, -0.7265760135f); q = fmaf(q, t, 0.7107068705f); q = fmaf(q, t, -0.142248368f); q = fmaf(q, t, 0.127414796f); q = q * t;
    const float e = __builtin_amdgcn_exp2f(v * v * -0.72134752044f);
    const float m = v * (q * e);
    return v < 0.f ? m : v - m;
}
__device__ __forceinline__ float half_sum_sel(float s, int hf) {
    s += dpp_get<0xB1, 0xF>(s); s += dpp_get<0x4E, 0xF>(s); s += dpp_get<0x124, 0xF>(s); s += dpp_get<0x128, 0xF>(s);
    s += dpp_get<0x142, 0xA>(s);
    const int lo = __builtin_amdgcn_readlane(__builtin_bit_cast(int, s), 31), hi = __builtin_amdgcn_readlane(__builtin_bit_cast(int, s), 63);
    return __builtin_bit_cast(float, hf ? hi : lo);
}
__device__ __forceinline__ v6u ld6(const unsigned char* p) { const v4u a = *(const v4u_a8*)p; const v2u b = *(const v2u*)(p + 16); return (v6u){a.x, a.y, a.z, a.w, b.x, b.y}; }
__device__ __forceinline__ void p13a_peer_u(Frame& F) {
    const int lane = F.lane, tg = lane >> 2, un = lane & 3;
    const bf16* H2 = (const bf16*)(F.ws + WS_H);
    const int* EIDX = (const int*)(F.ws + WS_OB + 64 * MiB);
    unsigned short* PD = (unsigned short*)(F.ws + WS_R1 + 128 * MiB);
    const int classes = F.G < 8 ? F.G : 8, cls = (int)blockIdx.x % classes, nwg = (F.G - cls + classes - 1) / classes;
    const int ws = ((int)blockIdx.x / classes) * NWAVES + F.wave, nws = nwg * NWAVES;
    for (int x = cls; x < 8; x += classes) {
        const unsigned char* UX = F.ws + ws_eux(x) + 32 * un;
        for (int grp = ws; grp < NLAT / 16; grp += nws) {
            const int t = grp * 16 + tg;
            unsigned hp[16];
#pragma unroll
            for (int q = 0; q < 4; ++q) { const v4u a = *(const v4u*)(H2 + (size_t)t * D + 128 * x + 32 * un + 8 * q); hp[4 * q] = a.x; hp[4 * q + 1] = a.y; hp[4 * q + 2] = a.z; hp[4 * q + 3] = a.w; }
            LAS unsigned* IDL = (LAS unsigned*)(F.lds + F.wave * 8448);
            { const v4u* src = (const v4u*)(EIDX + (size_t)grp * 16 * NPEER) + lane; v4u tmp[8];
#pragma unroll
                for (int j = 0; j < 8; ++j) tmp[j] = src[64 * j];
#pragma unroll
                for (int j = 0; j < 8; ++j) { const int f = 64 * j + lane; *(LAS v4u*)(IDL + (f >> 5) * 132 + 4 * (f & 31)) = tmp[j]; } }
            const LAS v4u* ep = (const LAS v4u*)(IDL + tg * 132);
            unsigned short* pd = PD + ((size_t)x * NLAT + t) * NPEER;
            v6u U0[4], U1[4], U2[4], U3[4];
#define PU_LOAD(U, e_) do { _Pragma("unroll") for (int j_ = 0; j_ < 4; ++j_) U[j_] = ld6(UX + (size_t)(e_)[j_] * 128); } while (0)
#define PU_COMP(U, s4) do { f32x4 dq_; _Pragma("unroll") for (int j_ = 0; j_ < 4; ++j_) { const v32bf ub_ = __builtin_amdgcn_cvt_scalef32_pk32_bf16_fp6(U[j_], 1.0f); float d_ = 0.f; \
                _Pragma("unroll") for (int i_ = 0; i_ < 16; ++i_) { const bf2_t a_ = {ub_[2 * i_], ub_[2 * i_ + 1]}; d_ = __builtin_amdgcn_fdot2_f32_bf16(a_, __builtin_bit_cast(bf2_t, hp[i_]), d_, false); } \
                d_ += dpp_get<0xB1, 0xF>(d_); d_ += dpp_get<0x4E, 0xF>(d_); dq_[j_] = d_; } \
            if (un == 0) *(v2u*)(pd + 4 * (s4)) = (v2u){pk2(dq_[0], dq_[1]), pk2(dq_[2], dq_[3])}; } while (0)
            v4u e3 = ep[3];
            { const v4u e0 = ep[0], e1 = ep[1], e2 = ep[2]; PU_LOAD(U0, e0); PU_LOAD(U1, e1); PU_LOAD(U2, e2); }
            for (int s4 = 0; s4 < 32; s4 += 4) {
                const int nb = s4 + 4 < 32 ? s4 + 4 : 28;
                const v4u n0 = ep[nb], n1 = ep[nb + 1], n2 = ep[nb + 2], n3 = ep[nb + 3];
                PU_LOAD(U3, e3); PU_COMP(U0, s4);
                PU_LOAD(U0, n0); PU_COMP(U1, s4 + 1);
                PU_LOAD(U1, n1); PU_COMP(U2, s4 + 2);
                PU_LOAD(U2, n2); PU_COMP(U3, s4 + 3);
                e3 = n3;
            }
#undef PU_LOAD
#undef PU_COMP
        }
    }
}
__device__ __forceinline__ void p13_peer(Frame& F) {
    const float* final_norm_w = late_arg(22);
    const int gw = blockIdx.x * NWAVES + F.wave, NGW = F.G * NWAVES, lane = F.lane, hf = lane >> 5, li = lane & 31;
    const float* MOD = (const float*)(F.ws + WS_MOD); const bf16* X1 = (const bf16*)(F.ws + WS_R1);
    const unsigned char* EV6 = F.ws + WS_EV6;
    const int* EIDX = (const int*)(F.ws + WS_OB + 64 * MiB); const float* EG = (const float*)(F.ws + WS_OB + 80 * MiB); const float* ESC = (const float*)(F.ws + WS_ESC);
    const unsigned short* PD = (const unsigned short*)(F.ws + WS_R1 + 128 * MiB);
    int eN0 = 0, eN1 = 0; unsigned pN0[8], pN1[8]; float uN0 = 0.f, uN1 = 0.f, gN0 = 0.f, gN1 = 0.f, vN0 = 0.f, vN1 = 0.f;
#define PEER_TOK(tt) do { eN0 = EIDX[(size_t)(tt) * NPEER + lane]; eN1 = EIDX[(size_t)(tt) * NPEER + 64 + lane]; \
        gN0 = EG[(size_t)(tt) * NPEER + lane]; gN1 = EG[(size_t)(tt) * NPEER + 64 + lane]; \
        _Pragma("unroll") for (int x_ = 0; x_ < 8; ++x_) { pN0[x_] = PD[((size_t)x_ * NLAT + (tt)) * NPEER + lane]; pN1[x_] = PD[((size_t)x_ * NLAT + (tt)) * NPEER + 64 + lane]; } } while (0)
#define PEER_SC() do { uN0 = ESC[eN0]; uN1 = ESC[eN1]; vN0 = ESC[16384 + eN0]; vN1 = ESC[16384 + eN1]; } while (0)
    if (gw < NLAT) { PEER_TOK(gw); PEER_SC(); }
    for (int t = gw; t < NLAT; t += NGW) {
        float y[32];
#pragma unroll
        for (int i = 0; i < 32; ++i) y[i] = 0.f;
        const int ei0 = eN0, ei1 = eN1;
        float d0 = 0.f, d1 = 0.f;
#pragma unroll
        for (int x_ = 0; x_ < 8; ++x_) { d0 += __builtin_bit_cast(float, pN0[x_] << 16); d1 += __builtin_bit_cast(float, pN1[x_] << 16); }
        const int ac0 = __builtin_bit_cast(int, gelu_erf(d0 * uN0) * (gN0 * vN0)), ac1 = __builtin_bit_cast(int, gelu_erf(d1 * uN1) * (gN1 * vN1));
        { const int tn = t + NGW < NLAT ? t + NGW : t; PEER_TOK(tn); }
        constexpr int NPB = 4;
        v6u V0[NPB], V1[NPB]; int A0[NPB], A1[NPB];
#define PEER_LOAD(V, A, bt) do { const bool lo_ = (bt) < 32 / NPB; const int se_ = lo_ ? ei0 : ei1, sa_ = lo_ ? ac0 : ac1; \
            _Pragma("unroll") for (int p_ = 0; p_ < NPB; ++p_) { const int sl_ = ((((bt) * 2 * NPB + 2 * p_) & 63) + hf) << 2; \
                const unsigned off_ = (unsigned)__builtin_amdgcn_ds_bpermute(sl_, se_) * 768u + 24u * (unsigned)li; \
                V[p_] = ld6(EV6 + off_); A[p_] = __builtin_amdgcn_ds_bpermute(sl_, sa_); } } while (0)
#define PEER_COMP(V, A) do { \
            _Pragma("unroll") for (int p_ = 0; p_ < NPB; ++p_) { const float act_ = __builtin_bit_cast(float, A[p_]); \
                const v32f vv_ = __builtin_amdgcn_cvt_scalef32_pk32_f32_fp6(V[p_], 1.0f); \
                _Pragma("unroll") for (int j_ = 0; j_ < 32; ++j_) y[j_] = fmaf(act_, vv_[j_], y[j_]); } } while (0)
        PEER_LOAD(V0, A0, 0);
        for (int bt = 0; bt < 32 / NPB; bt += 2) {
            PEER_LOAD(V1, A1, bt + 1);
            PEER_COMP(V0, A0);
            PEER_LOAD(V0, A0, bt + 2);
            PEER_COMP(V1, A1);
        }
        PEER_SC();
        for (int bt = 32 / NPB; bt < 64 / NPB; bt += 2) {
            PEER_LOAD(V1, A1, bt + 1);
            PEER_COMP(V0, A0);
            PEER_LOAD(V0, A0, bt + 2 < 64 / NPB ? bt + 2 : 64 / NPB - 1);
            PEER_COMP(V1, A1);
        }
#undef PEER_LOAD
#undef PEER_COMP
        float yy[16];
#pragma unroll
        for (int i = 0; i < 16; ++i) { const float a = y[i] + __shfl_xor(y[i], 32), b = y[16 + i] + __shfl_xor(y[16 + i], 32); yy[i] = hf ? b : a; }
        const float* g2 = MOD + (size_t)(t >> 13) * 6144 + 5120;
        const int ch0 = 32 * li + 16 * hf;
        float x2[16]; float ss = 0.f;
        const v4u xa = *(const v4u*)(X1 + (size_t)t * D + ch0), xb = *(const v4u*)(X1 + (size_t)t * D + ch0 + 8);
#pragma unroll
        for (int q = 0; q < 4; ++q) { const int col = ch0 + 4 * q;
            const unsigned w0 = q < 2 ? xa[2 * q] : xb[2 * q - 4], w1 = q < 2 ? xa[2 * q + 1] : xb[2 * q - 3];
            const f32x4 xv = (f32x4){bflo(w0), bfhi(w0), bflo(w1), bfhi(w1)}, gv = *(const f32x4*)(g2 + col);
#pragma unroll
            for (int i = 0; i < 4; ++i) { const float v = xv[i] + gv[i] * yy[q * 4 + i]; x2[q * 4 + i] = v; ss += v * v; } }
        const float r = rsqrtf(wave_sum(ss) * (1.f / D) + EPS);
#pragma unroll
        for (int q = 0; q < 4; ++q) { const int col = ch0 + 4 * q; const f32x4 wv = *(const f32x4*)(final_norm_w + col); f32x4 o;
#pragma unroll
            for (int i = 0; i < 4; ++i) o[i] = x2[q * 4 + i] * r * wv[i];
            *(f32x4*)(F.out + (size_t)t * D + col) = o; }
    }
}
#undef PEER_TOK
#undef PEER_SC
struct Args { const float* in[23]; float* out; unsigned char* ws; };
__global__ void __launch_bounds__(NT, 2) fwd_megakernel(Args args) {
    extern __shared__ __attribute__((aligned(16))) unsigned char lds[];
    Frame F;
    F.lds = (LAS unsigned char*)lds;
    F.tid = threadIdx.x; F.lane = F.tid & 63; F.wave = __builtin_amdgcn_readfirstlane(F.tid >> 6); F.G = gridDim.x;
    F.x = args.in[0]; F.c = args.in[1]; F.ctx = args.in[2]; F.c_ctx = args.in[3]; F.w_ada = args.in[4]; F.b_ada = args.in[5]; F.norm1_w = args.in[6]; F.w_in = args.in[7];
    F.lb_logits = args.in[12]; F.w_pa = args.in[14];
    F.w_pb = args.in[15]; F.w_o = args.in[16]; F.w_query = args.in[18]; F.sub_keys = args.in[19];
    F.out = args.out; F.ws = args.ws;
    volatile LAS unsigned* MISC = (volatile LAS unsigned*)(F.lds + MISC_OFF);
    if (F.tid < 64) MISC[F.tid] = 0u;
    __syncthreads();
    XcdBarrier bar = xcd_barrier_post((unsigned*)(F.ws + WS_CTL) + CW_BAR, MISC + 8);
#define GRID_BAR() xcd_barrier(bar)
    unsigned char* ws = F.ws;
    bf16* OA = (bf16*)F.out;
    bf16* OB = (bf16*)(ws + WS_OB);

#ifndef PROBE_MASK
#define PROBE_MASK 0
#endif
#define PHASE_IDS() do { asm volatile("" : "+v"(F.tid)); F.lane = F.tid & 63; { GAS unsigned char* wg_ = (GAS unsigned char*)F.ws; GAS float* og_ = (GAS float*)F.out; asm volatile("" : "+s"(wg_), "+s"(og_)); F.ws = (unsigned char*)wg_; F.out = (float*)og_; } ws = F.ws; OA = (bf16*)F.out; OB = (bf16*)(ws + WS_OB); } while (0)
#define PH(k, ...) do { PHASE_IDS(); __VA_ARGS__; if ((PROBE_MASK >> (k)) & 1) { GRID_BAR(); __VA_ARGS__; } } while (0)
    PH(0, p0_prologue(F));
    GRID_BAR();
    PH(1, p1_h(F));
    GRID_BAR();
    PH(2, {
        pg8::Gemm g{(const pg8::bf16_t*)(ws + WS_H), (const pg8::bf16_t*)(ws + WS_WTA), NROW, NA, D}; pg8::StaticOrder S; S.init(NROW, NA, F.G, (int)blockIdx.x);
        pg8::EpiA E{(pg8::bf16_t*)(ws + WS_R1), (float*)(ws + WS_AB), late_arg(9), late_arg(10)};
        pg8::gemm_phase<pg8::EpiA, pg8::StaticOrder, true, true>(F.lds, g, S, E);
    });
    GRID_BAR();
    PH(3, p2b_gdn_prep(F));
    GRID_BAR();
    PH(15, p3a_gdn_tw(F));
    GRID_BAR();
    PH(4, p3_gdn_chunk(F, OA));
    GRID_BAR();
    PH(5, {
        pg8::Gemm g{(const pg8::bf16_t*)(ws + WS_H), (const pg8::bf16_t*)(ws + WS_WTB), NROW, 4096, D}; pg8::StaticOrder S; S.init(NROW, 4096, F.G, (int)blockIdx.x);
        pg8::EpiB E{(pg8::bf16_t*)(ws + WS_R1), (const float*)(ws + WS_LB)};
        pg8::gemm_phase<pg8::EpiB, pg8::StaticOrder, true, true>(F.lds, g, S, E);
    });
    GRID_BAR();
    PH(6, { p5_hg_chunk(F, OB); if (F.G < 256) side_work(F, (int)blockIdx.x, F.G); else if ((int)blockIdx.x < 128) side_work(F, (int)blockIdx.x, 128); });
    GRID_BAR();
    PHASE_IDS();
    {
        pg8::Gemm g{(const pg8::bf16_t*)(ws + WS_H) + (size_t)NCTX * D, (const pg8::bf16_t*)(ws + WS_WTC), NLAT, 4096, D}; pg8::StaticOrder S; S.init(NLAT, 4096, F.G, (int)blockIdx.x);
        pg8::EpiC E{(pg8::bf16_t*)(ws + WS_R1), (const pg8::bf16_t*)OA, (pg8::bf16_t*)(ws + WS_R1 + 128 * MiB), (pg8::bf16_t*)OB, late_arg(11), late_arg(13), (LAS float*)(F.lds + RING_BYTES)};
        pg8::gemm_phase<pg8::EpiC, pg8::StaticOrder, true, true>(F.lds, g, S, E);
    }
    GRID_BAR();
    PH(8, {
        pg8::Gemm g{(const pg8::bf16_t*)(ws + WS_R1 + 128 * MiB), (const pg8::bf16_t*)(ws + WS_WTPA), NLAT, 1024, 2048}; pg8::StaticOrder S; S.init(NLAT, 1024, F.G, (int)blockIdx.x);
        pg8::EpiMerge E{(pg8::bf16_t*)(OA + (size_t)NLAT * 1024), (const pg8::bf16_t*)(ws + WS_R1)};
        pg8::gemm_phase<pg8::EpiMerge, pg8::StaticOrder, true, true>(F.lds, g, S, E);
    });
    GRID_BAR();
    PH(10, {
        pg8::Gemm g{(const pg8::bf16_t*)(OA + (size_t)NLAT * 1024), (const pg8::bf16_t*)(ws + WS_WTO), NLAT, 1024, D}; pg8::StaticOrder S; S.init(NLAT, 1024, F.G, (int)blockIdx.x);
        pg8::EpiResid E{(pg8::bf16_t*)(ws + WS_R1), late_arg(0), (const float*)(ws + WS_MOD)};
        pg8::gemm_phase<pg8::EpiResid, pg8::StaticOrder, true, true>(F.lds, g, S, E);
    });
    GRID_BAR();
    PH(11, p10_h2(F));
    GRID_BAR();
    PH(12, {
        pg8::Gemm g{(const pg8::bf16_t*)(ws + WS_H), (const pg8::bf16_t*)(ws + WS_WTF), NLAT, 2048, D}; pg8::StaticOrder S; S.init(NLAT, 2048, F.G, (int)blockIdx.x);
        pg8::EpiScoreT E{(unsigned short*)(ws + WS_R1 + 128 * MiB)};
        pg8::gemm_phase<pg8::EpiScoreT, pg8::StaticOrder, true, true>(F.lds, g, S, E);
    });
    GRID_BAR();
    PH(13, p12_topk(F));
    GRID_BAR();
    PH(14, p13a_peer_u(F));
    GRID_BAR();
    PH(16, p13_peer(F));
}

extern "C" void kernel_launch(void* const* d_in, const int* in_sizes, int n_in, void* d_out, int out_size, void* d_ws, size_t ws_size, hipStream_t stream) {
    static int grid = 0;
    if (grid == 0) {
        if (n_in != 23 || ws_size < WS_END) { fprintf(stderr, "kernel_launch: unexpected n_in %d or ws_size %zu (< %zu)\n", n_in, ws_size, (size_t)WS_END); grid = -1; return; }
        int dev = 0, cus = 0, per_cu = 0;
        if (hipGetDevice(&dev) != hipSuccess || hipDeviceGetAttribute(&cus, hipDeviceAttributeMultiprocessorCount, dev) != hipSuccess) { grid = -1; return; }
        if (hipFuncSetAttribute((const void*)fwd_megakernel, hipFuncAttributeMaxDynamicSharedMemorySize, LDS_BYTES) != hipSuccess) { fprintf(stderr, "kernel_launch: hipFuncSetAttribute failed\n"); grid = -1; return; }
        if (hipOccupancyMaxActiveBlocksPerMultiprocessor(&per_cu, (const void*)fwd_megakernel, NT, LDS_BYTES) != hipSuccess || per_cu < 1) { fprintf(stderr, "kernel_launch: occupancy query says %d\n", per_cu); per_cu = 1; }
        (void)hipGetLastError();
        grid = cus;
    }
    if (grid < 0) return;
    (void)hipMemsetAsync((char*)d_ws + WS_CTL, 0, CTL_ZERO_BYTES, stream);
    Args a{};
    for (int i = 0; i < 23; ++i) a.in[i] = (const float*)d_in[i];
    a.out = (float*)d_out; a.ws = (unsigned char*)d_ws;
    hipLaunchKernelGGL(fwd_megakernel, dim3(grid), dim3(NT), LDS_BYTES, stream, a);
}
```
